# Optimizing an MI355X kernel written in HIP

```python
import math
import jax, jax.numpy as jnp
from jax import lax
import numpy as np

D_MODEL = 1024
BATCH = 4
SEQ = 4096
DEPTH = 2
DEC_BATCH = 16
DEC_SEQ = 4096
PAST_LEN = 128

GRID_W = 64
MIX_W = D_MODEL
GROUP_W = MIX_W // 4
DA_HEADS = 4
DA_DV = GROUP_W // DA_HEADS
DA_DQK = DA_DV // 2
MLA_HEADS = 4
MLA_Q_RANK = 192
MLA_KV_RANK = 128
MLA_NOPE = 64
MLA_ROPE = 32
MLA_DV = GROUP_W // MLA_HEADS
MLA_ROPE_THETA = 10000.0
DIL_HEADS = 4
DIL_DH = GROUP_W // DIL_HEADS
DIL_PATTERNS = ((128, 1), (512, 4), (2048, 16))
DIL_QBLOCK = 64
NA_HEADS = 4
NA_DH = GROUP_W // NA_HEADS
NA_KR = 8
NA_KC = 16
ROPE_THETA = 500000.0
ROPE_FRACTION = 4
N_EXPERTS = 16
EC_FACTOR = 2
D_FF_EXPERT = 2816
DEEPNORM_ALPHA = (2.0 * DEPTH) ** 0.25
DEEPNORM_BETA = (8.0 * DEPTH) ** -0.25
IN_SIZES = (DA_HEADS * 2 * DA_DQK, DA_HEADS * 2 * DA_DQK, DA_HEADS * DA_DV,
            MLA_Q_RANK, MLA_KV_RANK, MLA_ROPE,
            DIL_HEADS * DIL_DH, DIL_HEADS * DIL_DH, DIL_HEADS * DIL_DH,
            NA_HEADS * NA_DH, NA_HEADS * NA_DH, NA_HEADS * NA_DH)
IN_COLS = sum(IN_SIZES)
Q_BLOCK = 128
NEG_INF = -1e30
LN_EPS = 1e-5
RMS_EPS = 1e-6
F32 = jnp.float32

kernel_name = 'hybrid_parallel_head_encoder'


def _split_points(sizes):
    return [int(s) for s in np.cumsum(np.array(sizes))[:-1]]


def _bhtd(a):
    return a.transpose(0, 2, 1, 3)


def _merge(a):
    B, H, T, d = a.shape
    return a.transpose(0, 2, 1, 3).reshape(B, T, H * d)


def layer_norm(x, g, b):
    xf = x.astype(F32)
    mu = jnp.mean(xf, -1, keepdims=True)
    var = jnp.mean(jnp.square(xf - mu), -1, keepdims=True)
    y = (xf - mu) * lax.rsqrt(var + LN_EPS)
    return (y * g.astype(F32) + b.astype(F32)).astype(x.dtype)


def rms_norm(x, g):
    xf = x.astype(F32)
    y = xf * lax.rsqrt(jnp.mean(jnp.square(xf), -1, keepdims=True) + RMS_EPS)
    return (y * g.astype(F32)).astype(x.dtype)


def rope(x, pos, rot_dim, theta):
    half = rot_dim // 2
    inv = theta ** (-jnp.arange(half, dtype=F32) / half)
    ang = pos.astype(F32)[:, None] * inv[None, :]
    cos = jnp.cos(ang)[:, None, :].astype(x.dtype)
    sin = jnp.sin(ang)[:, None, :].astype(x.dtype)
    x1 = x[..., :half]
    x2 = x[..., half:rot_dim]
    return jnp.concatenate([x1 * cos - x2 * sin, x2 * cos + x1 * sin, x[..., rot_dim:]], axis=-1)


def diff_attention(q1, q2, k1, k2, v, lam):
    B, H, T, dk = q1.shape
    dv = v.shape[-1]
    nq = T // Q_BLOCK
    scale = dk ** -0.5
    qs = jnp.stack([q1, q2], 0).reshape(2, B, H, nq, Q_BLOCK, dk).transpose(3, 0, 1, 2, 4, 5)
    ks = jnp.stack([k1, k2], 0)

    def block(qb):
        s = jnp.einsum('cbhqd,cbhkd->cbhqk', qb, ks, preferred_element_type=F32) * scale
        p = jax.nn.softmax(s, axis=-1)
        w = p[0] - lam * p[1]
        return jnp.einsum('bhqk,bhkd->bhqd', w.astype(v.dtype), v)

    o = lax.map(block, qs)
    return o.transpose(1, 2, 0, 3, 4).reshape(B, H, T, dv)


def mla_attention(q_nope, q_rope, k_nope, k_rope, v):
    B, H, T, dn = q_nope.shape
    dr = q_rope.shape[-1]
    dv = v.shape[-1]
    nq = T // Q_BLOCK
    scale = (dn + dr) ** -0.5
    qn = q_nope.reshape(B, H, nq, Q_BLOCK, dn).transpose(2, 0, 1, 3, 4)
    qr = q_rope.reshape(B, H, nq, Q_BLOCK, dr).transpose(2, 0, 1, 3, 4)

    def block(args):
        qn_b, qr_b = args
        s = (jnp.einsum('bhqd,bhkd->bhqk', qn_b, k_nope, preferred_element_type=F32)
             + jnp.einsum('bhqd,bkd->bhqk', qr_b, k_rope, preferred_element_type=F32)) * scale
        p = jax.nn.softmax(s, axis=-1)
        return jnp.einsum('bhqk,bhkd->bhqd', p.astype(v.dtype), v)

    o = lax.map(block, (qn, qr))
    return o.transpose(1, 2, 0, 3, 4).reshape(B, H, T, dv)


def dilated_branch(q, k, v, window, dil):
    B, H, T, dh = q.shape
    half = window // (2 * dil)
    L = T // dil
    qb = math.gcd(L, DIL_QBLOCK)
    nb = L // qb
    span = qb + 2 * half

    def sub(a):
        return a.reshape(B, H, L, dil, dh).transpose(0, 1, 3, 2, 4)

    qs = sub(q).reshape(B, H, dil, nb, qb, dh)
    pad = ((0, 0), (0, 0), (0, 0), (half, half), (0, 0))
    kp = jnp.pad(sub(k), pad)
    vp = jnp.pad(sub(v), pad)
    idx = jnp.arange(nb)[:, None] * qb + jnp.arange(span)[None, :]
    kb = kp[:, :, :, idx]
    vb = vp[:, :, :, idx]
    s = jnp.einsum('bhrnqe,bhrnke->bhrnqk', qs, kb, preferred_element_type=F32) * (dh ** -0.5)
    qpos = jnp.arange(nb)[:, None] * qb + jnp.arange(qb)[None, :]
    kpos = idx - half
    rel = kpos[:, None, :] - qpos[:, :, None]
    valid = (jnp.abs(rel) <= half) & (kpos[:, None, :] >= 0) & (kpos[:, None, :] < L)
    s = jnp.where(valid, s, NEG_INF)
    lse = jax.nn.logsumexp(s, axis=-1)
    p = jnp.exp(s - lse[..., None])
    o = jnp.einsum('bhrnqk,bhrnke->bhrnqe', p.astype(v.dtype), vb)
    o = o.reshape(B, H, dil, L, dh).transpose(0, 1, 3, 2, 4).reshape(B, H, T, dh)
    lse = lse.reshape(B, H, dil, L).transpose(0, 1, 3, 2).reshape(B, H, T)
    return o, lse


def dilated_attention(q, k, v):
    branches = [dilated_branch(q, k, v, w, d) for (w, d) in DIL_PATTERNS]
    outs = jnp.stack([o for (o, _) in branches], 0)
    wts = jax.nn.softmax(jnp.stack([s for (_, s) in branches], 0), axis=0)
    o = jnp.einsum('pbht,pbhtd->bhtd', wts, outs.astype(F32))
    return o.astype(q.dtype)


def neighbourhood_attention(q, k, v, rpb):
    B, H, T, dh = q.shape
    rows = T // GRID_W
    kr = min(NA_KR, rows)
    r = jnp.arange(rows)
    rs = jnp.clip(r - kr // 2, 0, rows - kr)
    krow = rs[:, None] + jnp.arange(kr)[None, :]
    c = jnp.arange(GRID_W)
    cs = jnp.clip(c - NA_KC // 2, 0, GRID_W - NA_KC)
    colmask = (c[None, :] >= cs[:, None]) & (c[None, :] < cs[:, None] + NA_KC)
    qg = q.reshape(B, H, rows, GRID_W, dh)
    kg = k.reshape(B, H, rows, GRID_W, dh)[:, :, krow]
    vg = v.reshape(B, H, rows, GRID_W, dh)[:, :, krow]
    s = jnp.einsum('bhrqd,bhrkcd->bhrqkc', qg, kg, preferred_element_type=F32) * (dh ** -0.5)
    ri = krow - r[:, None] + (NA_KR - 1)
    ci = jnp.clip(c[None, :] - c[:, None] + (NA_KC - 1), 0, 2 * NA_KC - 2)
    bias = rpb[:, ri[:, None, :, None], ci[None, :, None, :]].astype(F32)
    s = jnp.where(colmask[:, None, :], s + bias, NEG_INF)
    p = jax.nn.softmax(s.reshape(B, H, rows, GRID_W, kr * GRID_W), axis=-1)
    p = p.reshape(B, H, rows, GRID_W, kr, GRID_W)
    o = jnp.einsum('bhrqkc,bhrkcd->bhrqd', p.astype(v.dtype), vg)
    return o.reshape(B, H, T, dh)


def token_mixers(h, l, w_in, w_uq, w_ukv, q_norm_g, kv_norm_g, da_lq1, da_lk1, da_lq2, da_lk2,
                 da_subln_g, na_rpb, w_out):
    B, T, _ = h.shape
    pos = jnp.arange(T)
    u = h @ w_in[l]
    (a_q, a_k, a_v, b_cq, b_ckv, b_kr, c_q, c_k, c_v, d_q, d_k, d_v) = jnp.split(
        u, _split_points(IN_SIZES), axis=-1)

    a_rot = DA_DQK // ROPE_FRACTION
    aq = rope(a_q.reshape(B, T, 2 * DA_HEADS, DA_DQK), pos, a_rot, ROPE_THETA).reshape(B, T, DA_HEADS, 2, DA_DQK)
    ak = rope(a_k.reshape(B, T, 2 * DA_HEADS, DA_DQK), pos, a_rot, ROPE_THETA).reshape(B, T, DA_HEADS, 2, DA_DQK)
    av = a_v.reshape(B, T, DA_HEADS, DA_DV)
    lam_init = 0.8 - 0.6 * math.exp(-0.3 * l)
    lam = (jnp.exp(jnp.sum(da_lq1[l].astype(F32) * da_lk1[l].astype(F32)))
           - jnp.exp(jnp.sum(da_lq2[l].astype(F32) * da_lk2[l].astype(F32))) + lam_init)
    oa = diff_attention(_bhtd(aq[:, :, :, 0]), _bhtd(aq[:, :, :, 1]),
                        _bhtd(ak[:, :, :, 0]), _bhtd(ak[:, :, :, 1]), _bhtd(av), lam)
    oa = _merge(rms_norm(oa, da_subln_g[l]) * (1.0 - lam_init))

    qb = (rms_norm(b_cq, q_norm_g[l]) @ w_uq[l]).reshape(B, T, MLA_HEADS, MLA_NOPE + MLA_ROPE)
    qb_nope = qb[..., :MLA_NOPE]
    qb_rope = rope(qb[..., MLA_NOPE:], pos, MLA_ROPE, MLA_ROPE_THETA)
    kv = (rms_norm(b_ckv, kv_norm_g[l]) @ w_ukv[l]).reshape(B, T, MLA_HEADS, MLA_NOPE + MLA_DV)
    kb_nope = kv[..., :MLA_NOPE]
    vb = kv[..., MLA_NOPE:]
    kb_rope = rope(b_kr[:, :, None, :], pos, MLA_ROPE, MLA_ROPE_THETA)[:, :, 0]
    ob = _merge(mla_attention(_bhtd(qb_nope), _bhtd(qb_rope), _bhtd(kb_nope), kb_rope, _bhtd(vb)))

    c_rot = DIL_DH // ROPE_FRACTION
    qc = rope(c_q.reshape(B, T, DIL_HEADS, DIL_DH), pos, c_rot, ROPE_THETA)
    kc = rope(c_k.reshape(B, T, DIL_HEADS, DIL_DH), pos, c_rot, ROPE_THETA)
    vc = c_v.reshape(B, T, DIL_HEADS, DIL_DH)
    oc = _merge(dilated_attention(_bhtd(qc), _bhtd(kc), _bhtd(vc)))

    od = _merge(neighbourhood_attention(_bhtd(d_q.reshape(B, T, NA_HEADS, NA_DH)),
                                        _bhtd(d_k.reshape(B, T, NA_HEADS, NA_DH)),
                                        _bhtd(d_v.reshape(B, T, NA_HEADS, NA_DH)), na_rpb[l]))

    return jnp.concatenate([oa, ob, oc, od], axis=-1) @ w_out[l]


def expert_choice_ffn(h, w_router, w_gate, w_up, w_down):
    B, T, D = h.shape
    xf = h.reshape(B * T, D)
    n = B * T
    cap = EC_FACTOR * n // N_EXPERTS
    aff = jax.nn.softmax((xf @ w_router).astype(F32), axis=-1)
    gates, idx = lax.top_k(aff.T, cap)

    def expert(args):
        ix, gt, wg, wu, wd = args
        xe = xf[ix]
        ye = (jax.nn.silu(xe @ wg) * (xe @ wu)) @ wd
        return ye * gt[:, None].astype(ye.dtype)

    ye = lax.map(expert, (idx, gates, w_gate, w_up, w_down))
    out = jnp.zeros_like(xf).at[idx.reshape(-1)].add(ye.reshape(-1, D).astype(xf.dtype))
    return out.reshape(B, T, D)


def encoder_trunk(x, c, w_in, w_uq, w_ukv, q_norm_g, kv_norm_g, da_lq1, da_lk1, da_lq2, da_lk2,
                  da_subln_g, na_rpb, w_out, w_ada, b_ada, ln1_g, ln1_b, ln2_g, ln2_b,
                  w_router, w_e_gate, w_e_up, w_e_down):
    for l in range(DEPTH):
        mod = jax.nn.silu(c) @ w_ada[l] + b_ada[l]
        sh1, sc1, g1, sh2, sc2, g2 = jnp.split(mod[:, None, :], 6, axis=-1)
        h = x * (1.0 + sc1) + sh1
        m = token_mixers(h, l, w_in, w_uq, w_ukv, q_norm_g, kv_norm_g, da_lq1, da_lk1, da_lq2,
                         da_lk2, da_subln_g, na_rpb, w_out)
        x = layer_norm(DEEPNORM_ALPHA * x + (1.0 + g1) * m, ln1_g[l], ln1_b[l])
        h = x * (1.0 + sc2) + sh2
        f = expert_choice_ffn(h, w_router[l], w_e_gate[l], w_e_up[l], w_e_down[l])
        x = layer_norm(DEEPNORM_ALPHA * x + (1.0 + g2) * f, ln2_g[l], ln2_b[l])
    return x


def setup_inputs(seed: int = 0) -> dict:
    key = jax.random.key(seed)
    ks = jax.random.split(key, 32)

    def nrm(k, shape, scale):
        return jax.random.normal(k, shape, jnp.float32) * scale

    def gain(k, shape):
        return 1.0 + 0.02 * jax.random.normal(k, shape, jnp.float32)

    L = DEPTH
    return {
        'x_prompt': nrm(ks[0], (BATCH, SEQ, D_MODEL), 1.0),
        'x_sample': nrm(ks[1], (DEC_BATCH, DEC_SEQ, D_MODEL), 1.0),
        'c_prompt': nrm(ks[2], (BATCH, D_MODEL), 1.0),
        'c_sample': nrm(ks[3], (DEC_BATCH, D_MODEL), 1.0),
        'w_in': nrm(ks[4], (L, D_MODEL, IN_COLS), D_MODEL ** -0.5),
        'w_uq': nrm(ks[5], (L, MLA_Q_RANK, MLA_HEADS * (MLA_NOPE + MLA_ROPE)), MLA_Q_RANK ** -0.5),
        'w_ukv': nrm(ks[6], (L, MLA_KV_RANK, MLA_HEADS * (MLA_NOPE + MLA_DV)), MLA_KV_RANK ** -0.5),
        'q_norm_g': gain(ks[7], (L, MLA_Q_RANK)),
        'kv_norm_g': gain(ks[8], (L, MLA_KV_RANK)),
        'da_lq1': nrm(ks[9], (L, DA_DQK), 0.1),
        'da_lk1': nrm(ks[10], (L, DA_DQK), 0.1),
        'da_lq2': nrm(ks[11], (L, DA_DQK), 0.1),
        'da_lk2': nrm(ks[12], (L, DA_DQK), 0.1),
        'da_subln_g': gain(ks[13], (L, DA_DV)),
        'na_rpb': nrm(ks[14], (L, NA_HEADS, 2 * NA_KR - 1, 2 * NA_KC - 1), 0.02),
        'w_out': nrm(ks[15], (L, MIX_W, D_MODEL), MIX_W ** -0.5 * DEEPNORM_BETA),
        'w_ada': nrm(ks[16], (L, D_MODEL, 6 * D_MODEL), 0.1 * D_MODEL ** -0.5),
        'b_ada': nrm(ks[17], (L, 6 * D_MODEL), 0.02),
        'ln1_g': gain(ks[18], (L, D_MODEL)),
        'ln1_b': nrm(ks[19], (L, D_MODEL), 0.02),
        'ln2_g': gain(ks[20], (L, D_MODEL)),
        'ln2_b': nrm(ks[21], (L, D_MODEL), 0.02),
        'w_router': nrm(ks[22], (L, D_MODEL, N_EXPERTS), D_MODEL ** -0.5),
        'w_e_gate': nrm(ks[23], (L, N_EXPERTS, D_MODEL, D_FF_EXPERT), D_MODEL ** -0.5),
        'w_e_up': nrm(ks[24], (L, N_EXPERTS, D_MODEL, D_FF_EXPERT), D_MODEL ** -0.5),
        'w_e_down': nrm(ks[25], (L, N_EXPERTS, D_FF_EXPERT, D_MODEL), D_FF_EXPERT ** -0.5 * DEEPNORM_BETA),
    }


def reference(x_prompt, x_sample, c_prompt, c_sample, w_in, w_uq, w_ukv, q_norm_g, kv_norm_g,
              da_lq1, da_lk1, da_lq2, da_lk2, da_subln_g, na_rpb, w_out, w_ada, b_ada,
              ln1_g, ln1_b, ln2_g, ln2_b, w_router, w_e_gate, w_e_up, w_e_down):
    y_prompt = encoder_trunk(x_prompt, c_prompt, w_in, w_uq, w_ukv, q_norm_g, kv_norm_g,
                             da_lq1, da_lk1, da_lq2, da_lk2, da_subln_g, na_rpb, w_out,
                             w_ada, b_ada, ln1_g, ln1_b, ln2_g, ln2_b,
                             w_router, w_e_gate, w_e_up, w_e_down)
    y_sample = encoder_trunk(x_sample, c_sample, w_in, w_uq, w_ukv, q_norm_g, kv_norm_g,
                             da_lq1, da_lk1, da_lq2, da_lk2, da_subln_g, na_rpb, w_out,
                             w_ada, b_ada, ln1_g, ln1_b, ln2_g, ln2_b,
                             w_router, w_e_gate, w_e_up, w_e_down)
    return (y_prompt, y_sample)
```

```cpp
#include <hip/hip_runtime.h>
#include <cstdio>
#include <cstdint>
#include <cmath>

#define DI __device__ __forceinline__
#define LAS __attribute__((address_space(3)))
#define GAS __attribute__((address_space(1)))
#define RLX_AGENT __ATOMIC_RELAXED, __HIP_MEMORY_SCOPE_AGENT
#define LDS_WAIT() asm volatile("s_waitcnt lgkmcnt(0)" ::: "memory")
#define VM_WAIT() asm volatile("s_waitcnt vmcnt(0)" ::: "memory")

typedef unsigned short bf16_t;
typedef short bf16x8 __attribute__((ext_vector_type(8)));
typedef short s16x4 __attribute__((ext_vector_type(4)));
typedef float f32x4 __attribute__((ext_vector_type(4)));
typedef float f32x2 __attribute__((ext_vector_type(2)));
typedef int i32x2 __attribute__((ext_vector_type(2)));
typedef float f32x16 __attribute__((ext_vector_type(16)));
typedef unsigned u32x4 __attribute__((ext_vector_type(4)));
typedef unsigned u32x2 __attribute__((ext_vector_type(2)));
typedef __bf16 bf16v2 __attribute__((ext_vector_type(2)));
typedef int i32x8 __attribute__((ext_vector_type(8)));
typedef int i32x4 __attribute__((ext_vector_type(4)));

constexpr int D = 1024, T = 4096, NSEQ = 20, M = NSEQ * T  , MP = 4 * T  ;
constexpr int NL = 2, NE = 16, FF = 2816;
constexpr int N1 = 2816;
constexpr int NROWS = 2 * M;
constexpr int CHUNK_PANELS = 640, NCHUNK = 1;
constexpr float LN_EPS = 1e-5f, RMS_EPS = 1e-6f;
constexpr float ALPHA = 1.41421356237309515f;
constexpr float LOG2E = 1.44269504088896341f;
constexpr int NWAVES = 8;

DI unsigned pk2(float lo, float hi) { bf16v2 v = {(__bf16)lo, (__bf16)hi}; return __builtin_bit_cast(unsigned, v); }
DI float bf_lo(unsigned w) { return __uint_as_float(w << 16); }
DI float bf_hi(unsigned w) { return __uint_as_float(w & 0xffff0000u); }
DI int opaque_int(int v) { asm volatile("" : "+s"(v)); return v; }
DI float wave_sum(float v) {
#pragma unroll
    for (int o = 1; o < 64; o <<= 1) v += __shfl_xor(v, o);
    return v;
}

namespace pg8 {
constexpr int BM = 256, BK = 64, HALF = 128, HTB = HALF * BK * 2, STAGE_BYTES = 8 * HTB, NXCD = 8, WGM = 8;
__host__ __device__ __forceinline__ int lds_byte(int r, int c) { const int st = (r >> 4) * 2 + (c >> 5), rr = r & 15, cc = c & 31, ob = rr * 64 + cc * 2; return st * 1024 + (ob ^ (((ob >> 9) & 1) << 5)); }
__host__ __device__ __forceinline__ void stage_rc(int b, int& R, int& C) { const int st = b / 1024, sb = b % 1024, swz = sb ^ (((sb >> 9) & 1) << 5); R = (st >> 1) * 16 + swz / 64; C = (st & 1) * 32 + (swz % 64) / 2; }
__host__ __device__ __forceinline__ int perm32(int rho) { const int n = rho >> 4, i = rho & 15; return 8 * (i >> 2) + 4 * n + (i & 3); }

struct Unit { int pm, pn; };
struct StaticOrder {
    int nM, nN, nwg, G, c;
    __host__ __device__ void init(int nM_, int nN_, int G_, int c_) { nM = nM_; nN = nN_; nwg = nM * nN; G = G_; c = c_; }
    __host__ __device__ bool next(int i, Unit& u) const {
        const long L = (long)i * G + c; if (L >= nwg) return false;
        int wgid = (int)L; { const int q = nwg / NXCD, r = nwg % NXCD, xcd = wgid % NXCD, off = wgid / NXCD; wgid = (xcd < r ? xcd * (q + 1) : r * (q + 1) + (xcd - r) * q) + off; }
        const int nig = WGM * nN, gid = wgid / nig, fm = gid * WGM, gsz = (nM - fm) < WGM ? (nM - fm) : WGM;
        u.pm = fm + ((wgid % nig) % gsz); u.pn = (wgid % nig) / gsz; return true;
    }
};

template <class Epi, class Prob, class Sched>
DI void gemm_phase(LAS unsigned char* lds, const Prob& P, const Sched& S, const Epi& E, const int tid) {
    const int wid = __builtin_amdgcn_readfirstlane(tid >> 6), lane = tid & 63, wr = wid >> 2, wc = wid & 3, fr = lane & 15, fq = lane >> 4;
    constexpr bool F8 = Prob::FP8;
    const int K = P.K, rowb = F8 ? K : 2 * K, nt = rowb / (BK * 2);
    unsigned voffB[2]; int RA[2]; unsigned CA2[2];
#pragma unroll
    for (int i = 0; i < 2; ++i) { int R, C; stage_rc(tid * 16 + i * 8192, R, C); const int Rb = (R & ~31) + perm32(R & 31);
        voffB[i] = (unsigned)(Rb * rowb) + (unsigned)C * 2u; RA[i] = R; CA2[i] = (unsigned)C * 2u; }
    const size_t kstep = (size_t)(BK * 2);
    const size_t hstep = (size_t)HALF * rowb;
    const unsigned ldsw = (unsigned)wid * 1024u;
    const int aoff = lds_byte(wr * 64 + fr, fq * 8), boff = lds_byte(wc * 32 + fr, fq * 8);
    constexpr int off1 = 1024;
    const unsigned adrA = (unsigned)(size_t)lds + (unsigned)aoff, adrB = (unsigned)(size_t)lds + 4u * HTB + (unsigned)boff;
#define PG8_SA(b, h) (((b) * 2 + (h)) * HTB)
#define PG8_SB(b, h) ((4 + (b) * 2 + (h)) * HTB)
#define PG8_STAGE(bufoff, gbase, voff) do { _Pragma("unroll") for (int _i = 0; _i < 2; ++_i) \
        __builtin_amdgcn_global_load_lds((const unsigned*)((const char*)(gbase) + (voff)[_i]), (LAS unsigned*)(lds + (bufoff) + ldsw + _i * 8192), 16, 0, 0); } while (0)
#define PG8_DSR(dst, addr, off) asm volatile("ds_read_b128 %0, %1 offset:%2" : "=v"(dst) : "v"(addr), "n"(off) : "memory")
#define PG8_LDA(dst, b, h) do { \
        PG8_DSR(dst[0][0], adrA, ((b) * 2 + (h)) * HTB + 0 * 2048 + 0 * 1024); PG8_DSR(dst[0][1], adrA, ((b) * 2 + (h)) * HTB + 0 * 2048 + 1 * 1024); \
        PG8_DSR(dst[1][0], adrA, ((b) * 2 + (h)) * HTB + 1 * 2048 + 0 * 1024); PG8_DSR(dst[1][1], adrA, ((b) * 2 + (h)) * HTB + 1 * 2048 + 1 * 1024); \
        PG8_DSR(dst[2][0], adrA, ((b) * 2 + (h)) * HTB + 2 * 2048 + 0 * 1024); PG8_DSR(dst[2][1], adrA, ((b) * 2 + (h)) * HTB + 2 * 2048 + 1 * 1024); \
        PG8_DSR(dst[3][0], adrA, ((b) * 2 + (h)) * HTB + 3 * 2048 + 0 * 1024); PG8_DSR(dst[3][1], adrA, ((b) * 2 + (h)) * HTB + 3 * 2048 + 1 * 1024); } while (0)
#define PG8_LDB(dst, b, h) do { \
        PG8_DSR(dst[0][0], adrB, ((b) * 2 + (h)) * HTB + 0 * 2048 + 0 * 1024); PG8_DSR(dst[0][1], adrB, ((b) * 2 + (h)) * HTB + 0 * 2048 + 1 * 1024); \
        PG8_DSR(dst[1][0], adrB, ((b) * 2 + (h)) * HTB + 1 * 2048 + 0 * 1024); PG8_DSR(dst[1][1], adrB, ((b) * 2 + (h)) * HTB + 1 * 2048 + 1 * 1024); } while (0)
#define PG8_MFMA(ai, bj, m, n, At, Bt) do { \
        if constexpr (F8) { const i32x8 b8_ = __builtin_bit_cast(i32x8, __builtin_shufflevector(Bt[n][0], Bt[n][1], 0, 1, 2, 3, 4, 5, 6, 7, 8, 9, 10, 11, 12, 13, 14, 15)), a8_ = __builtin_bit_cast(i32x8, __builtin_shufflevector(At[m][0], At[m][1], 0, 1, 2, 3, 4, 5, 6, 7, 8, 9, 10, 11, 12, 13, 14, 15)); \
            asm volatile("v_mfma_scale_f32_16x16x128_f8f6f4 %0, %1, %2, %0, %3, %4 op_sel_hi:[0,0,0]" : "+v"(acc[ai][bj][m][n]) : "v"(b8_), "v"(a8_), "v"(sclB), "v"(sclA)); } \
        else { _Pragma("unroll") for (int k = 0; k < 2; ++k) acc[ai][bj][m][n] = __builtin_amdgcn_mfma_f32_16x16x32_bf16(Bt[n][k], At[m][k], acc[ai][bj][m][n], 0, 0, 0); } } while (0)
#define PG8_WL(N, At, m) asm volatile("s_waitcnt lgkmcnt(" #N ")" : "+v"(At[m][0]), "+v"(At[m][1]) :: "memory")
#define PG8_WLB(N, At, Ba, Bb) asm volatile("s_waitcnt lgkmcnt(" #N ")" : "+v"(At[0][0]), "+v"(At[0][1]), "+v"(Ba[0][0]), "+v"(Ba[0][1]), "+v"(Ba[1][0]), "+v"(Ba[1][1]), "+v"(Bb[0][0]), "+v"(Bb[0][1]), "+v"(Bb[1][0]), "+v"(Bb[1][1]) :: "memory")
#ifndef PG8_PRIO
#define PG8_PRIO 1
#endif
#define PG8_SETPRIO(x) do { if (PG8_PRIO) __builtin_amdgcn_s_setprio(x); } while (0)
#define PG8_MMA2(ai, At, Ba, Bb, FIRST) do { PG8_SETPRIO(1); \
        FIRST; PG8_MFMA(ai, 0, 0, 0, At, Ba); PG8_MFMA(ai, 0, 0, 1, At, Ba); \
        PG8_WL(4, At, 1); PG8_MFMA(ai, 0, 1, 0, At, Ba); PG8_MFMA(ai, 0, 1, 1, At, Ba); \
        PG8_WL(2, At, 2); PG8_MFMA(ai, 0, 2, 0, At, Ba); PG8_MFMA(ai, 0, 2, 1, At, Ba); \
        PG8_WL(0, At, 3); PG8_MFMA(ai, 0, 3, 0, At, Ba); PG8_MFMA(ai, 0, 3, 1, At, Ba); \
        PG8_SETPRIO(0); PG8_SETPRIO(1); \
        PG8_MFMA(ai, 1, 0, 0, At, Bb); PG8_MFMA(ai, 1, 0, 1, At, Bb); PG8_MFMA(ai, 1, 1, 0, At, Bb); PG8_MFMA(ai, 1, 1, 1, At, Bb); \
        PG8_MFMA(ai, 1, 2, 0, At, Bb); PG8_MFMA(ai, 1, 2, 1, At, Bb); PG8_MFMA(ai, 1, 3, 0, At, Bb); PG8_MFMA(ai, 1, 3, 1, At, Bb); \
        PG8_SETPRIO(0); } while (0)
#define PG8_WAIT_V(n) asm volatile("s_waitcnt vmcnt(" #n ")" ::: "memory")
#define PG8_WAIT_L(n) asm volatile("" ::: "memory")
#define PG8_BAR __builtin_amdgcn_s_barrier()
#define PG8_SCHED __builtin_amdgcn_sched_barrier(0)
    const int sclA = Prob::SCALE_A, sclB = Prob::SCALE_B;
    Unit cur, nxt; int ui = 0;
    if (!S.next(0, cur)) return;
    f32x4 acc[2][2][4][2];
#pragma unroll
    for (int a = 0; a < 2; ++a)
#pragma unroll
        for (int b = 0; b < 2; ++b)
#pragma unroll
            for (int m = 0; m < 4; ++m)
#pragma unroll
                for (int n = 0; n < 2; ++n) acc[a][b][m][n] = (f32x4){0.f, 0.f, 0.f, 0.f};
    bf16x8 At[4][2], B0[2][2], B1[2][2];
    unsigned aoC[2][2], aoN[2][2];
#pragma unroll
    for (int h = 0; h < 2; ++h)
#pragma unroll
        for (int i = 0; i < 2; ++i) { aoC[h][i] = P.a_off(cur, h * HALF + RA[i]) + CA2[i]; aoN[h][i] = aoC[h][i]; }
    const char* cA = P.a_base(cur); const char* cB = P.b_base(cur);
    PG8_STAGE(PG8_SB(0, 0), cB, voffB); PG8_STAGE(PG8_SB(0, 1), cB + hstep, voffB); PG8_STAGE(PG8_SA(0, 0), cA, aoC[0]); PG8_STAGE(PG8_SA(0, 1), cA, aoC[1]);
    if (wr == 1) PG8_BAR;
    PG8_WAIT_V(2); PG8_BAR;
    PG8_STAGE(PG8_SB(1, 0), cB + kstep, voffB); PG8_STAGE(PG8_SA(1, 0), cA + kstep, aoC[0]); PG8_STAGE(PG8_SB(1, 1), cB + hstep + kstep, voffB);
    PG8_WAIT_V(6); PG8_BAR;
    for (;;) {
        const bool has_next = S.next(ui + 1, nxt);
        const char* nA = has_next ? P.a_base(nxt) : cA; const char* nB = has_next ? P.b_base(nxt) : cB;
        int rawN[2][2]; const bool pendN = Prob::GATHER && has_next && nt >= 6;
        if constexpr (Prob::GATHER) {
#pragma unroll
            for (int h = 0; h < 2; ++h)
#pragma unroll
                for (int i = 0; i < 2; ++i) { const int* ip_ = P.idx_ptr(has_next ? nxt : cur, h * HALF + RA[i]); asm volatile("global_load_dword %0, %1, off" : "=v"(rawN[h][i]) : "v"(ip_) : "memory"); }
        }
        if (Prob::GATHER) {
            if (has_next && !pendN) {
#pragma unroll
                for (int h = 0; h < 2; ++h)
#pragma unroll
                    for (int i = 0; i < 2; ++i) aoN[h][i] = P.a_off(nxt, h * HALF + RA[i]) + CA2[i];
            } else if (!has_next) {
#pragma unroll
                for (int h = 0; h < 2; ++h)
#pragma unroll
                    for (int i = 0; i < 2; ++i) aoN[h][i] = aoC[h][i];
            }
        }
        for (int t = 0; t < nt; t += 2) {
            const bool last = (t == nt - 2);
            if constexpr (Prob::GATHER) {
                if (t == 2) asm volatile("" : "+v"(rawN[0][0]), "+v"(rawN[0][1]), "+v"(rawN[1][0]), "+v"(rawN[1][1]));
                if (pendN && t == 2) {
#pragma unroll
                    for (int h = 0; h < 2; ++h)
#pragma unroll
                        for (int i = 0; i < 2; ++i) aoN[h][i] = P.off_of_idx(rawN[h][i]) + CA2[i];
                }
            }
            const char* a1 = cA + (size_t)(t + 1) * kstep;
            const char* a2 = last ? nA : cA + (size_t)(t + 2) * kstep; const char* b2 = last ? nB : cB + (size_t)(t + 2) * kstep;
            const char* a3 = a2 + kstep; const char* b3 = b2 + kstep;
            unsigned ao2[2][2];
#pragma unroll
            for (int h = 0; h < 2; ++h)
#pragma unroll
                for (int i = 0; i < 2; ++i) ao2[h][i] = (Prob::GATHER && last) ? aoN[h][i] : aoC[h][i];
            PG8_LDB(B0, 0, 0); PG8_LDB(B1, 0, 1); PG8_SCHED; PG8_LDA(At, 0, 0); PG8_STAGE(PG8_SA(1, 1), a1, aoC[1]);
            PG8_WAIT_V(8); PG8_BAR; PG8_MMA2(0, At, B0, B1, PG8_WLB(6, At, B0, B1)); PG8_BAR; PG8_SCHED;
            PG8_LDA(At, 0, 1); PG8_STAGE(PG8_SB(0, 0), b2, voffB); PG8_STAGE(PG8_SB(0, 1), b2 + hstep, voffB); PG8_STAGE(PG8_SA(0, 0), a2, ao2[0]);
            PG8_WAIT_V(8); PG8_BAR; PG8_MMA2(1, At, B0, B1, PG8_WL(6, At, 0)); PG8_BAR; PG8_SCHED;
            PG8_LDB(B0, 1, 0); PG8_LDB(B1, 1, 1); PG8_SCHED; PG8_LDA(At, 1, 0); PG8_STAGE(PG8_SA(0, 1), a2, ao2[1]);
            PG8_WAIT_V(8); PG8_BAR; PG8_MMA2(0, At, B0, B1, PG8_WLB(6, At, B0, B1)); PG8_BAR; PG8_SCHED;
            PG8_LDA(At, 1, 1); PG8_STAGE(PG8_SB(1, 0), b3, voffB); PG8_STAGE(PG8_SB(1, 1), b3 + hstep, voffB); PG8_STAGE(PG8_SA(1, 0), a3, ao2[0]);
            PG8_WAIT_V(8); PG8_BAR; PG8_MMA2(1, At, B0, B1, PG8_WL(6, At, 0)); PG8_BAR; PG8_SCHED;
        }
        if (wr == 0) PG8_BAR;
        if constexpr (F8) { asm volatile("s_nop 15\n\ts_nop 15" ::: "memory"); }
        E(acc, cur, wr, wc, fr, fq);
        if (!has_next) break;
#pragma unroll
        for (int a = 0; a < 2; ++a)
#pragma unroll
            for (int b = 0; b < 2; ++b)
#pragma unroll
                for (int m = 0; m < 4; ++m)
#pragma unroll
                    for (int n = 0; n < 2; ++n) acc[a][b][m][n] = (f32x4){0.f, 0.f, 0.f, 0.f};
        cur = nxt; cA = nA; cB = nB; ++ui;
#pragma unroll
        for (int h = 0; h < 2; ++h)
#pragma unroll
            for (int i = 0; i < 2; ++i) aoC[h][i] = aoN[h][i];
        if (wr == 1) PG8_BAR;
    }
    PG8_WAIT_V(0);
    PG8_BAR;
#undef PG8_SA
#undef PG8_SB
#undef PG8_STAGE
#undef PG8_LDA
#undef PG8_LDB
#undef PG8_MMA2
#undef PG8_MFMA
#undef PG8_WL
#undef PG8_WLB
#undef PG8_DSR
#undef PG8_WAIT_V
#undef PG8_WAIT_L
#undef PG8_BAR
#undef PG8_SCHED
}
}
#define XB_TMO      128
#define XB_XCNT(j)  (256  + 64 * (j))
#define XB_XSUB(j)  (1280 + 64 * (j))
#define XB_XGEN(j)  (2304 + 64 * (j))
#define XB_TOP      3328
#define XB_TOPGEN   3392
#define XCD_BAR_WORDS 3456
#define XB_SPIN_CAP (1u << 18)

__device__ __forceinline__ unsigned xb_ld(unsigned* p)              { return __hip_atomic_load(p, __ATOMIC_RELAXED, __HIP_MEMORY_SCOPE_AGENT); }
__device__ __forceinline__ unsigned xb_add(unsigned* p, unsigned v) { return __hip_atomic_fetch_add(p, v, __ATOMIC_RELAXED, __HIP_MEMORY_SCOPE_AGENT); }
__device__ __forceinline__ unsigned xb_xcc_id() { return (unsigned)__builtin_amdgcn_s_getreg((3 << 11) | 20) & 0xFu; }
#define XB_SPIN(cond, bar) do { unsigned _sp = 0; while (cond) { __builtin_amdgcn_s_sleep(1); \
    if ((++_sp & 255u) == 0u) { if (xb_ld(&(bar)[XB_TMO])) break; if (_sp > XB_SPIN_CAP) { atomicAdd(&(bar)[XB_TMO], 1u); break; } } } } while (0)

struct XcdBarrier {
    unsigned* bar; unsigned x;
    volatile LAS unsigned* st;
};

__device__ __forceinline__ XcdBarrier xcd_barrier_post(unsigned* bar, volatile LAS unsigned* st) {
    XcdBarrier b; b.bar = bar; b.x = xb_xcc_id(); b.st = st;
    if (threadIdx.x == 0) (void)xb_add(&bar[XB_XCNT(b.x)], 1u);
    return b;
}
__device__ __forceinline__ void xcd_barrier_complete(unsigned* bar, unsigned x, unsigned& nloc, unsigned& nx) {
    const unsigned G = gridDim.x * gridDim.y * gridDim.z;
    unsigned sum, cnt, mine, sp = 0u;
    for (;;) {
        sum = 0u; cnt = 0u; mine = 0u;
#pragma unroll
        for (unsigned j = 0; j < 16; ++j) { const unsigned c = xb_ld(&bar[XB_XCNT(j)]); sum += c; cnt += (c > 0u) ? 1u : 0u; mine = (j == x) ? c : mine; }
        if (sum == G) break;
        __builtin_amdgcn_s_sleep(1);
        if ((++sp & 255u) == 0u) { if (xb_ld(&bar[XB_TMO])) break; if (sp > XB_SPIN_CAP) { atomicAdd(&bar[XB_TMO], 1u); break; } }
    }
    nloc = mine > 0u ? mine : 1u; nx = cnt > 0u ? cnt : 1u;
}

__device__ __forceinline__ void xcd_barrier(const XcdBarrier& b) {
    asm volatile("s_waitcnt vmcnt(0)" ::: "memory");
    __syncthreads();
    if (threadIdx.x == 0) {
        unsigned* bar = b.bar;
        __builtin_amdgcn_s_waitcnt(0);
        unsigned nloc = b.st[0], nx = b.st[1];
        if (nloc == 0u) { xcd_barrier_complete(bar, b.x, nloc, nx); b.st[0] = nloc; b.st[1] = nx; }
        const unsigned old = xb_add(&bar[XB_XSUB(b.x)], 1u);
        const unsigned gen = old / nloc;
        if (old + 1u == (gen + 1u) * nloc) {
            __builtin_amdgcn_fence(__ATOMIC_RELEASE, "agent");
            asm volatile("s_waitcnt vmcnt(0)" ::: "memory");
            const unsigned og = xb_add(&bar[XB_TOP], 1u);
            const unsigned tg = og / nx;
            if (og + 1u == (tg + 1u) * nx) xb_add(&bar[XB_TOPGEN], 1u);
            else XB_SPIN(xb_ld(&bar[XB_TOPGEN]) == tg, bar);
            __builtin_amdgcn_fence(__ATOMIC_ACQUIRE, "agent");
            xb_add(&bar[XB_XGEN(b.x)], 1u);
            asm volatile("s_waitcnt vmcnt(0)" ::: "memory");
        } else {
            XB_SPIN(xb_ld(&bar[XB_XGEN(b.x)]) == gen, bar);
            __builtin_amdgcn_fence(__ATOMIC_ACQUIRE, "agent");
            asm volatile("s_waitcnt vmcnt(0)" ::: "memory");
        }
    }
    __syncthreads();
}

constexpr size_t al256(size_t x) { return (x + 255) & ~(size_t)255; }
constexpr size_t WS_CTL = 0, CTL_BYTES = 65536;
constexpr size_t WS_MOD = WS_CTL + CTL_BYTES;
constexpr size_t WS_ROPEA = al256(WS_MOD + (size_t)NL * NSEQ * 6144 * 4);
constexpr size_t WS_ROPEC = WS_ROPEA + (size_t)T * 4 * 8;
constexpr size_t WS_ROPEB = WS_ROPEC + (size_t)T * 8 * 8;
constexpr size_t WS_WIN_T = WS_ROPEB + (size_t)T * 16 * 8;
constexpr size_t WS_WUQ_T = WS_WIN_T + (size_t)NL * N1 * D * 2;
constexpr size_t WS_WUKV_T = WS_WUQ_T + (size_t)NL * 384 * 192 * 2;
constexpr size_t WS_WOUT_T = WS_WUKV_T + (size_t)NL * 512 * 128 * 2;
constexpr size_t WS_WGU_T = WS_WOUT_T + (size_t)NL * D * D * 2;
constexpr size_t WS_WD_T = WS_WGU_T + (size_t)NL * NE * 2 * FF * D;
constexpr size_t WS_H8 = WS_WD_T + (size_t)NL * NE * D * FF;
constexpr size_t WS_HB = WS_H8 + (size_t)M * D;
constexpr size_t WS_AFFT = WS_HB + (size_t)M * D * 2;
constexpr size_t WS_SEL = WS_AFFT + (size_t)NE * M * 4;
constexpr size_t WS_IDX = WS_SEL + (size_t)NE * M * 4;
constexpr size_t WS_GATE = WS_IDX + (size_t)NROWS * 4;
constexpr size_t WS_R1 = WS_GATE + (size_t)NROWS * 4;
constexpr size_t USZ = (size_t)M * 256 * 2;
constexpr size_t WS_U = WS_R1;
constexpr size_t WS_UB = WS_U + 9 * USZ;
constexpr size_t WS_QB = WS_UB + (size_t)M * 512 * 2;
constexpr size_t WS_KB = WS_QB + (size_t)M * 384 * 2;
constexpr size_t WS_VB = WS_KB + (size_t)M * 384 * 2;
constexpr size_t WS_CAT = WS_VB + USZ;
constexpr size_t WS_END = WS_CAT + (size_t)M * D * 2;
constexpr size_t WS_MBUF = WS_R1;
constexpr size_t WS_ACT = WS_R1;
constexpr size_t WS_Y = WS_R1 + (size_t)CHUNK_PANELS * 256 * FF;
static_assert(WS_Y + (size_t)NROWS * D * 2 <= WS_END, "ws map");
static_assert(WS_MBUF + (size_t)M * D * 2 <= WS_CAT, "mbuf overlaps cat");

constexpr int LDS_BYTES = 147456;
constexpr int RING_BYTES = 131072, MISC_OFF = RING_BYTES + 320;

struct Params {
    const float* in[26];
    float* out; unsigned char* ws;
    double invA[4], invC[8], invB[16];
    float lam_init[2];
    int ph_lo, ph_hi;
};

typedef const __attribute__((address_space(4))) Params* CParams;
DI CParams launder_args() { CParams q = (CParams)__builtin_amdgcn_kernarg_segment_ptr(); asm volatile("" : "+s"(q)); return q; }
DI const float* x_in_row(CParams p, int t) { return t < MP ? p->in[0] + (size_t)t * D : p->in[1] + (size_t)(t - MP) * D; }
DI const float* x_row_of(const float* xp, const float* xs, int t) { return t < MP ? xp + (size_t)t * D : xs + (size_t)(t - MP) * D; }

template <int NS>
DI void tconv(const float* __restrict__ src, int ldn, bf16_t* __restrict__ dst, int ldk, LAS unsigned char* scr, int tid) {
    constexpr int NT = 32 * NS, F4R = NT / 4, RPP = 512 / F4R, NP = 64 / RPP, LSTR = 72;
    f32x4 v[NP];
    const int c4 = tid % F4R, r0 = tid / F4R;
#pragma unroll
    for (int p = 0; p < NP; ++p) v[p] = *(const f32x4*)(src + (size_t)(r0 + p * RPP) * ldn + 4 * c4);
    LAS bf16_t* t = (LAS bf16_t*)scr;
#pragma unroll
    for (int p = 0; p < NP; ++p) { const int k = r0 + p * RPP;
#pragma unroll
        for (int e = 0; e < 4; ++e) t[(4 * c4 + e) * LSTR + k] = (bf16_t)(pk2(v[p][e], 0.f) & 0xffffu); }
    __syncthreads();
    for (int c = tid; c < NT * 8; c += 512) { const int n = c >> 3, kc = c & 7; const u32x4 w = *(const LAS u32x4*)(t + n * LSTR + 8 * kc); *(u32x4*)(dst + (size_t)n * ldk + 8 * kc) = w; }
    __syncthreads();
}

struct ConvJob { const float* src; unsigned char* dst; int ldn, ldk; float scale; };
constexpr int CONV_JOBS_PER_LAYER = NE * 3 * 704;
DI ConvJob conv_job(CParams p, int l, int j) {
    const int e = j / 2112, r = j % 2112, ty = r / 704, q = r % 704, le = l * NE + e;
    ConvJob J;
    if (ty < 2) { const int kt = q / 44, nt = q % 44;
        J.src = p->in[23 + ty] + ((size_t)le * D + 64 * kt) * FF + 64 * nt; J.ldn = FF;
        J.scale = ty == 0 ? 256.f * LOG2E : 256.f * 0.69314718056f;
        J.dst = p->ws + WS_WGU_T + ((size_t)le * 2 * FF + 256 * (nt >> 1) + 128 * ty + 64 * (nt & 1)) * D + 64 * kt; J.ldk = D;
    } else { const int kt = q / 16, nt = q % 16;
        J.src = p->in[25] + ((size_t)le * FF + 64 * kt) * D + 64 * nt; J.ldn = D;
        J.dst = p->ws + WS_WD_T + ((size_t)le * D + 64 * nt) * FF + 64 * kt; J.ldk = FF; J.scale = 256.f; }
    return J;
}
DI void conv_load(const ConvJob& J, int lane, f32x4 (&v)[4][4]) {
    const int c4 = lane & 15, kq = lane >> 4;
#pragma unroll
    for (int i = 0; i < 4; ++i)
#pragma unroll
        for (int pp = 0; pp < 4; ++pp) v[i][pp] = __builtin_nontemporal_load((const f32x4*)(J.src + (size_t)(16 * i + 4 * kq + pp) * J.ldn + 4 * c4));
}
DI void conv_store(const ConvJob& J, int lane, const f32x4 (&v)[4][4], LAS unsigned char* scr  ) {
    constexpr int LSTR = 68;
    const int c4 = lane & 15, kq = lane >> 4;
#pragma unroll
    for (int i = 0; i < 4; ++i)
#pragma unroll
        for (int e = 0; e < 4; ++e) { int w = 0; w = __builtin_amdgcn_cvt_pk_fp8_f32(v[i][0][e] * J.scale, v[i][1][e] * J.scale, w, false); w = __builtin_amdgcn_cvt_pk_fp8_f32(v[i][2][e] * J.scale, v[i][3][e] * J.scale, w, true);
            *(LAS int*)(scr + (4 * c4 + e) * LSTR + 16 * i + 4 * kq) = w; }
    LDS_WAIT();
#pragma unroll
    for (int jn = 0; jn < 4; ++jn) { const int n = 16 * jn + (lane >> 2), kc = lane & 3; const LAS int* sp = (const LAS int*)(scr + n * LSTR + 16 * kc);
        const u32x4 w = {(unsigned)sp[0], (unsigned)sp[1], (unsigned)sp[2], (unsigned)sp[3]}; *(u32x4*)(J.dst + (size_t)n * J.ldk + 16 * kc) = w; }
    LDS_WAIT();
}
constexpr int CONV_EARLY = 15232;
DI void convert_experts_wave(CParams p, int l, LAS unsigned char* scr, int j0, int j1, int gw, int ngw, int lane) {
    if (j0 + gw >= j1) return;
    f32x4 v[4][4], vn[4][4];
    ConvJob J = conv_job(p, l, j0 + gw), Jn = J;
    conv_load(J, lane, v);
#pragma unroll 1
    for (int j = j0 + gw; j < j1; j += ngw) {
        const bool more = j + ngw < j1;
        if (more) { Jn = conv_job(p, l, j + ngw); conv_load(Jn, lane, vn); }
        conv_store(J, lane, v, scr);
        if (more) { J = Jn;
#pragma unroll
            for (int i = 0; i < 4; ++i)
#pragma unroll
                for (int q = 0; q < 4; ++q) v[i][q] = vn[i][q]; }
    }
}

DI int win_dst_row(int sb) {
    const int c = 32 * sb;
    if (c < 768) return c;
    if (c < 960) return 2304 + (c - 768);
    if (c < 1088) return 2560 + (c - 960);
    if (c < 1120) return 2688 + (c - 1088);
    return 768 + (c - 1120);
}

DI void prologue_a(CParams p, LAS unsigned char* lds, int tid, int wg, int G) {
    const int lane = tid & 63, wave = tid >> 6;
    if (wg < (NL * 6144) / 48) {
        LAS float* sc = (LAS float*)lds;
        LAS float* red = (LAS float*)(lds + 81920);
        for (int i = tid; i < NSEQ * D; i += 512) { const int b = i >> 10, k = i & 1023; const float c = b < 4 ? p->in[2][b * D + k] : p->in[3][(b - 4) * D + k]; sc[i] = c / (1.f + __expf(-c)); }
        __syncthreads();
        const int l = (wg * 48) / 6144, j0 = (wg * 48) % 6144, ln48 = lane < 48 ? lane : 47;
        const float* W = p->in[16] + (size_t)l * D * 6144 + j0 + ln48;
        float acc[NSEQ];
#pragma unroll
        for (int b = 0; b < NSEQ; ++b) acc[b] = 0.f;
#pragma unroll 1
        for (int k0 = wave * 128; k0 < wave * 128 + 128; k0 += 16) {
            float w[16];
#pragma unroll
            for (int kk = 0; kk < 16; ++kk) w[kk] = W[(size_t)(k0 + kk) * 6144];
#pragma unroll
            for (int k4 = 0; k4 < 4; ++k4) { asm volatile("" ::: "memory");
#pragma unroll
                for (int b = 0; b < NSEQ; ++b) { const f32x4 s = *(const LAS f32x4*)(sc + b * D + k0 + 4 * k4); acc[b] += s[0] * w[4 * k4] + s[1] * w[4 * k4 + 1] + s[2] * w[4 * k4 + 2] + s[3] * w[4 * k4 + 3]; } }
        }
#pragma unroll
        for (int b = 0; b < NSEQ; ++b) red[(wave * NSEQ + b) * 64 + lane] = acc[b];
        __syncthreads();
        float* MOD = (float*)(p->ws + WS_MOD);
        for (int i = tid; i < NSEQ * 64; i += 512) { const int b = i >> 6, ln = i & 63; if (ln >= 48) continue; float s = 0.f;
#pragma unroll
            for (int w = 0; w < 8; ++w) s += red[(w * NSEQ + b) * 64 + ln];
            MOD[((size_t)l * NSEQ + b) * 6144 + j0 + ln] = s + p->in[17][l * 6144 + j0 + ln]; }
        __syncthreads();
    }
    {
        bf16_t* WI = (bf16_t*)(p->ws + WS_WIN_T);
        const int gt = wg * 512 + tid, GT = G * 512;
        for (int i = gt; i < NL * 160 * (D / 8); i += GT) { const int l = i / (160 * 128), q = i % (160 * 128), rr = q >> 7, c8 = q & 127; const int row = rr < 64 ? 2496 + rr : 2720 + (rr - 64);
            *(u32x4*)(WI + ((size_t)l * N1 + row) * D + 8 * c8) = (u32x4){0u, 0u, 0u, 0u}; }
        bf16_t* WUQ = (bf16_t*)(p->ws + WS_WUQ_T); bf16_t* WUKV = (bf16_t*)(p->ws + WS_WUKV_T);
        for (int i = gt; i < NL * 384 * 192; i += GT) { const int l = i / (384 * 192), q = i % (384 * 192), n = q / 192, k = q % 192;
            WUQ[i] = (bf16_t)(pk2(p->in[5][((size_t)l * 192 + k) * 384 + n] * p->in[7][l * 192 + k], 0.f) & 0xffffu); }
        for (int i = gt; i < NL * 512 * 128; i += GT) { const int l = i / (512 * 128), q = i % (512 * 128), n = q / 128, k = q % 128;
            WUKV[i] = (bf16_t)(pk2(p->in[6][((size_t)l * 128 + k) * 512 + n] * p->in[8][l * 128 + k], 0.f) & 0xffffu); }
        f32x2* RA = (f32x2*)(p->ws + WS_ROPEA); f32x2* RC = (f32x2*)(p->ws + WS_ROPEC); f32x2* RB = (f32x2*)(p->ws + WS_ROPEB);
        for (int i = gt; i < T * 28; i += GT) { const int pos = i / 28, j = i % 28;
            const double inv = j < 4 ? p->invA[j] : j < 12 ? p->invC[j - 4] : p->invB[j - 12];
            double rev = (double)pos * inv * 0.15915494309189533577; rev -= __builtin_rint(rev);
            const float fr = (float)rev; const f32x2 cs = {__builtin_amdgcn_cosf(fr), __builtin_amdgcn_sinf(fr)};
            if (j < 4) RA[pos * 4 + j] = cs; else if (j < 12) RC[pos * 8 + (j - 4)] = cs; else RB[pos * 16 + (j - 12)] = cs; }
    }
}

constexpr int WCONV_JOBS = NL * 16 * 83 + NL * 16 * 32;
DI void wconv_job(CParams p, int j, int lane, LAS unsigned char* scr  ) {
    const float* src; bf16_t* dst; int ldn;
    if (j < NL * 16 * 83) { const int l = j / (16 * 83), q = j % (16 * 83), kt = q / 83, sb = q % 83;
        src = p->in[4] + ((size_t)l * D + 64 * kt) * 2656 + 32 * sb; ldn = 2656; dst = (bf16_t*)(p->ws + WS_WIN_T) + ((size_t)l * N1 + win_dst_row(sb)) * D + 64 * kt; }
    else { const int j2 = j - NL * 16 * 83, l = j2 >> 9, q = j2 & 511, kt = q >> 5, nb = q & 31;
        src = p->in[15] + ((size_t)l * D + 64 * kt) * D + 32 * nb; ldn = D; dst = (bf16_t*)(p->ws + WS_WOUT_T) + ((size_t)l * D + 32 * nb) * D + 64 * kt; }
    const int c4 = lane & 7, kq = lane >> 3;
    f32x4 v[2][4];
#pragma unroll
    for (int i = 0; i < 2; ++i)
#pragma unroll
        for (int pp = 0; pp < 4; ++pp) v[i][pp] = __builtin_nontemporal_load((const f32x4*)(src + (size_t)(32 * i + 4 * kq + pp) * ldn + 4 * c4));
    constexpr int LSTR = 136;
#pragma unroll
    for (int i = 0; i < 2; ++i)
#pragma unroll
        for (int e = 0; e < 4; ++e) { u32x2 w; w.x = pk2(v[i][0][e], v[i][1][e]); w.y = pk2(v[i][2][e], v[i][3][e]); *(LAS u32x2*)(scr + (4 * c4 + e) * LSTR + 64 * i + 8 * kq) = w; }
    LDS_WAIT();
#pragma unroll
    for (int jn = 0; jn < 4; ++jn) { const int n = 8 * jn + (lane >> 3), kc = lane & 7; const LAS u32x2* sp = (const LAS u32x2*)(scr + n * LSTR + 16 * kc);
        const u32x2 lo = sp[0], hi = sp[1]; *(u32x4*)(dst + (size_t)n * D + 8 * kc) = (u32x4){lo.x, lo.y, hi.x, hi.y}; }
    LDS_WAIT();
}
DI void prologue_b(CParams p, LAS unsigned char* lds, int tid, int wg, int G) {
    const int lane = tid & 63, gw = wg * NWAVES + (tid >> 6), NGW = G * NWAVES;
    for (int j = gw; j < WCONV_JOBS; j += NGW) wconv_job(p, j, lane, lds + (tid >> 6) * 4352);
    const float* MOD = (const float*)(p->ws + WS_MOD); bf16_t* HB = (bf16_t*)(p->ws + WS_HB);
    const int per = (((M + NGW - 1) / NGW) + 3) & ~3; const int t0 = gw * per, t1 = (t0 + per < M) ? t0 + per : M;
    int curb = -1; f32x4 scp[4], shp[4];
    const float* xin_p = p->in[0]; const float* xin_s = p->in[1];
    for (int t = t0; t < t1; t += 4) {
        const int b = t >> 12;
        if (b != curb) { curb = b; const float* mb = MOD + (size_t)b * 6144;
#pragma unroll
            for (int j = 0; j < 4; ++j) { shp[j] = *(const f32x4*)(mb + 4 * lane + 256 * j); scp[j] = *(const f32x4*)(mb + 1024 + 4 * lane + 256 * j) + 1.f; } }
        const float* xr = x_row_of(xin_p, xin_s, t);
        f32x4 x[4][4];
#pragma unroll
        for (int r = 0; r < 4; ++r)
#pragma unroll
            for (int j = 0; j < 4; ++j) x[r][j] = __builtin_nontemporal_load((const f32x4*)(xr + (size_t)r * D + 4 * lane + 256 * j));
#pragma unroll
        for (int r = 0; r < 4; ++r)
#pragma unroll
            for (int j = 0; j < 4; ++j) { const f32x4 h = x[r][j] * scp[j] + shp[j];
                u32x2 w; w.x = pk2(h[0], h[1]); w.y = pk2(h[2], h[3]); *(u32x2*)(HB + (size_t)(t + r) * D + 4 * lane + 256 * j) = w; }
    }
}
namespace pg8 {
struct ProbPlain {
    static constexpr bool GATHER = false, FP8 = false; static constexpr int SCALE_A = 0x7f7f7f7f, SCALE_B = 0x7f7f7f7f;
    const bf16_t* A; const bf16_t* Bt; int K;
    DI const char* a_base(const Unit& u) const { return (const char*)A + (size_t)u.pm * BM * K * 2; }
    DI unsigned a_off(const Unit&, int r) const { return (unsigned)(r * K) * 2u; }
    DI const char* b_base(const Unit& u) const { return (const char*)Bt + (size_t)u.pn * BM * K * 2; }
};
DI int panel_expert(int panel) { return panel < 128 ? (panel >> 3) : ((panel - 128) >> 5); }
struct ProbMoeUp {
    static constexpr bool GATHER = true, FP8 = true; static constexpr int SCALE_A = 0x7f7f7f7f, SCALE_B = 0x77777777;
    const unsigned char* H; const unsigned char* WGU; const int* idx; int chunk; int K;
    DI const char* a_base(const Unit&) const { return (const char*)H; }
    DI unsigned a_off(const Unit& u, int r) const { return (unsigned)idx[(chunk * CHUNK_PANELS + u.pm) * BM + r] * (unsigned)D; }
    DI const int* idx_ptr(const Unit& u, int r) const { return idx + (chunk * CHUNK_PANELS + u.pm) * BM + r; }
    DI unsigned off_of_idx(int ix) const { return (unsigned)ix * (unsigned)D; }
    DI const char* b_base(const Unit& u) const { return (const char*)WGU + ((size_t)panel_expert(chunk * CHUNK_PANELS + u.pm) * 2 * FF + (size_t)u.pn * BM) * D; }
};
struct ProbMoeDown {
    static constexpr bool GATHER = false, FP8 = true; static constexpr int SCALE_A = 0x7f7f7f7f, SCALE_B = 0x77777777;
    const unsigned char* ACT; const unsigned char* WD; int chunk; int K;
    DI const char* a_base(const Unit& u) const { return (const char*)ACT + (size_t)u.pm * BM * FF; }
    DI unsigned a_off(const Unit&, int r) const { return (unsigned)(r * FF); }
    DI const char* b_base(const Unit& u) const { return (const char*)WD + ((size_t)panel_expert(chunk * CHUNK_PANELS + u.pm) * D + (size_t)u.pn * BM) * FF; }
};

struct EpiStore {
    bf16_t* O; int ldc;
    DI void operator()(const f32x4 (&acc)[2][2][4][2], const Unit& u, int wr, int wc, int fr, int fq) const {
        const int row0 = u.pm * BM + wr * 64 + fr, col0 = u.pn * BM + wc * 32 + 8 * fq;
#pragma unroll
        for (int ai = 0; ai < 2; ++ai)
#pragma unroll
            for (int m = 0; m < 4; ++m) { bf16_t* rowp = O + (size_t)(row0 + ai * HALF + m * 16) * ldc + col0;
#pragma unroll
                for (int bj = 0; bj < 2; ++bj) { const f32x4 v0 = acc[ai][bj][m][0], v1 = acc[ai][bj][m][1];
                    u32x4 w; w.x = pk2(v0[0], v0[1]); w.y = pk2(v0[2], v0[3]); w.z = pk2(v1[0], v1[1]); w.w = pk2(v1[2], v1[3]);
                    *(u32x4*)(rowp + bj * HALF) = w; } }
    }
};

struct EpiInProj {
    bf16_t* U; bf16_t* UB; const f32x2* ropeA; const f32x2* ropeC; float scA, scC;
    DI void operator()(const f32x4 (&acc)[2][2][4][2], const Unit& u, int wr, int wc, int fr, int fq) const {
        const int pn = u.pn;
        bf16_t* base; int ldc, colt;
        if (pn < 9) { base = U + (size_t)pn * M * 256; ldc = 256; colt = 0; } else { base = UB; ldc = 512; colt = (pn - 9) * 256; }
        const float sc = (pn == 0) ? scA : ((pn == 3 || pn == 6) ? scC : 1.f);
        const int mode = (pn <= 1) ? 1 : ((pn == 3 || pn == 4) ? 2 : 0);
        const int row0 = u.pm * BM + wr * 64 + fr, col0 = colt + wc * 32 + 8 * fq;
#pragma unroll
        for (int ai = 0; ai < 2; ++ai) {
            f32x4 csb[4][4];
            if (mode == 1) {
#pragma unroll
                for (int m = 0; m < 4; ++m) { const f32x4* rp = (const f32x4*)(ropeA + ((row0 + ai * HALF + m * 16) & (T - 1)) * 4); csb[m][0] = rp[0]; csb[m][1] = rp[1]; }
            } else if (mode == 2) {
#pragma unroll
                for (int m = 0; m < 4; ++m) { const f32x4* rp = (const f32x4*)(ropeC + ((row0 + ai * HALF + m * 16) & (T - 1)) * 8); csb[m][0] = rp[0]; csb[m][1] = rp[1]; csb[m][2] = rp[2]; csb[m][3] = rp[3]; }
            }
#pragma unroll
            for (int m = 0; m < 4; ++m) {
                const int row = row0 + ai * HALF + m * 16;
                f32x4 cs[4];
                cs[0] = csb[m][0]; cs[1] = csb[m][1]; cs[2] = mode == 1 ? csb[m][0] : csb[m][2]; cs[3] = mode == 1 ? csb[m][1] : csb[m][3];
#pragma unroll
                for (int bj = 0; bj < 2; ++bj) {
                    f32x4 v0 = acc[ai][bj][m][0], v1 = acc[ai][bj][m][1];
                    if (mode == 1) {
                        if (fq == 0) {
#pragma unroll
                            for (int e = 0; e < 4; ++e) { const float c = cs[e >> 1][2 * (e & 1)], s = cs[e >> 1][2 * (e & 1) + 1]; const float x1 = v0[e], x2 = v1[e]; v0[e] = x1 * c - x2 * s; v1[e] = x2 * c + x1 * s; }
                        }
                    } else if (mode == 2) {
                        if ((wc & 1) == 0) {
                            f32x4 o0, o1;
#pragma unroll
                            for (int e = 0; e < 4; ++e) { o0[e] = __shfl_xor(v0[e], 16); o1[e] = __shfl_xor(v1[e], 16); }
                            if (fq < 2) {
                                const float sg = fq == 0 ? -1.f : 1.f;
#pragma unroll
                                for (int e = 0; e < 4; ++e) {
                                    const float c0 = cs[e >> 1][2 * (e & 1)], s0 = cs[e >> 1][2 * (e & 1) + 1];
                                    const float c1 = cs[2 + (e >> 1)][2 * (e & 1)], s1 = cs[2 + (e >> 1)][2 * (e & 1) + 1];
                                    v0[e] = v0[e] * c0 + sg * o0[e] * s0; v1[e] = v1[e] * c1 + sg * o1[e] * s1; }
                            }
                        }
                    }
                    v0 = v0 * sc; v1 = v1 * sc;
                    u32x4 w; w.x = pk2(v0[0], v0[1]); w.y = pk2(v0[2], v0[3]); w.z = pk2(v1[0], v1[1]); w.w = pk2(v1[2], v1[3]);
                    *(u32x4*)(base + (size_t)row * ldc + col0 + bj * HALF) = w;
                }
            }
        }
    }
};

DI unsigned pk4_fp8(float a, float b, float c, float d) { int w = 0; w = __builtin_amdgcn_cvt_pk_fp8_f32(a, b, w, false); w = __builtin_amdgcn_cvt_pk_fp8_f32(c, d, w, true); return (unsigned)w; }
struct EpiSwiGLU {
    unsigned char* ACT;
    DI void operator()(const f32x4 (&acc)[2][2][4][2], const Unit& u, int wr, int wc, int fr, int fq) const {
        const int row0 = u.pm * BM + wr * 64 + fr, col0 = u.pn * HALF + wc * 32 + 8 * fq;
#pragma unroll
        for (int ai = 0; ai < 2; ++ai)
#pragma unroll
            for (int m = 0; m < 4; ++m) {
                f32x4 r[2];
#pragma unroll
                for (int n = 0; n < 2; ++n)
#pragma unroll
                    for (int e = 0; e < 4; ++e) { const float g = acc[ai][0][m][n][e], up = acc[ai][1][m][n][e];
                        r[n][e] = (g * up) * __builtin_amdgcn_rcpf(1.f + __builtin_amdgcn_exp2f(-g)); }
                u32x2 w; w.x = pk4_fp8(r[0][0], r[0][1], r[0][2], r[0][3]); w.y = pk4_fp8(r[1][0], r[1][1], r[1][2], r[1][3]);
                *(u32x2*)(ACT + (size_t)(row0 + ai * HALF + m * 16) * FF + col0) = w;
            }
    }
};

struct EpiDown {
    bf16_t* Y; const float* gate; int chunk;
    DI void operator()(const f32x4 (&acc)[2][2][4][2], const Unit& u, int wr, int wc, int fr, int fq) const {
        const int row0 = (chunk * CHUNK_PANELS + u.pm) * BM + wr * 64 + fr, col0 = u.pn * BM + wc * 32 + 8 * fq;
        float gv[2][4];
#pragma unroll
        for (int ai = 0; ai < 2; ++ai)
#pragma unroll
            for (int m = 0; m < 4; ++m) gv[ai][m] = gate[row0 + ai * HALF + m * 16];
        __builtin_amdgcn_sched_barrier(0);
#pragma unroll
        for (int ai = 0; ai < 2; ++ai)
#pragma unroll
            for (int m = 0; m < 4; ++m) { const int row = row0 + ai * HALF + m * 16; const float g = gv[ai][m]; bf16_t* rowp = Y + (size_t)row * D + col0;
#pragma unroll
                for (int bj = 0; bj < 2; ++bj) { const f32x4 v0 = acc[ai][bj][m][0] * g, v1 = acc[ai][bj][m][1] * g;
                    u32x4 w; w.x = pk2(v0[0], v0[1]); w.y = pk2(v0[2], v0[3]); w.z = pk2(v1[0], v1[1]); w.w = pk2(v1[2], v1[3]);
                    *(u32x4*)(rowp + bj * HALF) = w; } }
    }
};
}
DI void mla_phase(CParams p, int l, LAS unsigned char* lds, int tid, int wg, int G) {
    const int lane = tid & 63, wave = __builtin_amdgcn_readfirstlane(tid >> 6);
    const int j16 = lane & 15, kq = lane >> 4;
    const bf16_t* UB = (const bf16_t*)(p->ws + WS_UB);
    const bf16_t* WUQ = (const bf16_t*)(p->ws + WS_WUQ_T) + (size_t)l * 384 * 192;
    const bf16_t* WUKV = (const bf16_t*)(p->ws + WS_WUKV_T) + (size_t)l * 512 * 128;
    const f32x2* RB = (const f32x2*)(p->ws + WS_ROPEB);
    bf16_t* QB = (bf16_t*)(p->ws + WS_QB); bf16_t* KB = (bf16_t*)(p->ws + WS_KB); bf16_t* VB = (bf16_t*)(p->ws + WS_VB);
    const float qscale = 0.10206207261596575f * LOG2E;
    constexpr int QP = 400, KP = 272;
    for (int task = wg; task < 4 * (M / 256); task += G) {
        const int part = ((G & 3) == 0 ? task + task / G : task) & 3, tok0 = (task >> 2) * 256 + wave * 32;
        __syncthreads();
        if (part < 2) {
            for (int c = wave; c < 75; c += NWAVES) { const int L = c * 64 + lane, row = L / 25, cc = L - row * 25;
                __builtin_amdgcn_global_load_lds((const unsigned*)(WUQ + (size_t)(192 * part + row) * 192 + (cc < 24 ? cc : 0) * 8), (LAS unsigned*)(lds + c * 1024), 16, 0, 0); }
        } else {
            for (int c = wave; c < 68; c += NWAVES) { const int L = c * 64 + lane, row = L / 17, cc = L - row * 17;
                __builtin_amdgcn_global_load_lds((const unsigned*)(WUKV + (size_t)(256 * (part - 2) + row) * 128 + (cc < 16 ? cc : 0) * 8), (LAS unsigned*)(lds + c * 1024), 16, 0, 0); }
        }
        if (part < 2) {
            bf16x8 xf[2][6]; float rs[2];
#pragma unroll
            for (int rt = 0; rt < 2; ++rt)
#pragma unroll
                for (int s = 0; s < 6; ++s) xf[rt][s] = __builtin_bit_cast(bf16x8, *(const u32x4*)(UB + (size_t)(tok0 + 16 * rt + j16) * 512 + 32 * s + 8 * kq));
            __builtin_amdgcn_sched_barrier(0);
#pragma unroll
            for (int rt = 0; rt < 2; ++rt) { float ss = 0.f;
#pragma unroll
                for (int s = 0; s < 6; ++s) { const u32x4 w = __builtin_bit_cast(u32x4, xf[rt][s]);
#pragma unroll
                    for (int e = 0; e < 4; ++e) { const float a = bf_lo(w[e]), b = bf_hi(w[e]); ss += a * a + b * b; } }
                ss += __shfl_xor(ss, 16); ss += __shfl_xor(ss, 32);
                rs[rt] = __builtin_amdgcn_rsqf(ss * (1.f / 192.f) + RMS_EPS) * qscale; }
            f32x4 rc01[2], rc23[2];
#pragma unroll
            for (int rt = 0; rt < 2; ++rt) { const f32x4* rp = (const f32x4*)(RB + (size_t)((tok0 + 16 * rt + j16) & (T - 1)) * 16 + 4 * kq); rc01[rt] = rp[0]; rc23[rt] = rp[1]; }
            asm volatile("s_waitcnt vmcnt(0)" ::: "memory"); __syncthreads();
#pragma unroll 1
            for (int npl = 0; npl < 6; ++npl) { const int np = 6 * part + npl;
                bf16x8 W[6][2];
#pragma unroll
                for (int s_ = 0; s_ < 6; ++s_)
#pragma unroll
                    for (int nn = 0; nn < 2; ++nn) W[s_][nn] = *(const LAS bf16x8*)(lds + (32 * npl + 16 * nn + j16) * QP + 64 * s_ + 16 * kq);
                f32x4 acc[2][2];
#pragma unroll
                for (int a2 = 0; a2 < 2; ++a2)
#pragma unroll
                    for (int b2 = 0; b2 < 2; ++b2) acc[a2][b2] = (f32x4){0.f, 0.f, 0.f, 0.f};
#pragma unroll
                for (int s_ = 0; s_ < 6; ++s_)
#pragma unroll
                    for (int nn = 0; nn < 2; ++nn)
#pragma unroll
                        for (int rt = 0; rt < 2; ++rt) acc[rt][nn] = __builtin_amdgcn_mfma_f32_16x16x32_bf16(W[s_][nn], xf[rt][s_], acc[rt][nn], 0, 0, 0);
                const bool rope = (np % 3) == 2;
#pragma unroll
                for (int rt = 0; rt < 2; ++rt) { const int tok = tok0 + 16 * rt + j16;
                    f32x4 v0 = acc[rt][0] * rs[rt], v1 = acc[rt][1] * rs[rt];
                    if (rope) { const f32x4 c01 = rc01[rt], c23 = rc23[rt];
#pragma unroll
                        for (int e = 0; e < 4; ++e) { const float c = (e < 2 ? c01 : c23)[2 * (e & 1)], sn = (e < 2 ? c01 : c23)[2 * (e & 1) + 1]; const float x1 = v0[e], x2 = v1[e]; v0[e] = x1 * c - x2 * sn; v1[e] = x2 * c + x1 * sn; } }
                    u32x2 w0, w1; w0.x = pk2(v0[0], v0[1]); w0.y = pk2(v0[2], v0[3]); w1.x = pk2(v1[0], v1[1]); w1.y = pk2(v1[2], v1[3]);
                    *(u32x2*)(QB + (size_t)tok * 384 + 32 * np + 4 * kq) = w0; *(u32x2*)(QB + (size_t)tok * 384 + 32 * np + 16 + 4 * kq) = w1; }
            }
        }
        else {
            bf16x8 xf[2][4]; float rs[2];
#pragma unroll
            for (int rt = 0; rt < 2; ++rt)
#pragma unroll
                for (int s = 0; s < 4; ++s) xf[rt][s] = __builtin_bit_cast(bf16x8, *(const u32x4*)(UB + (size_t)(tok0 + 16 * rt + j16) * 512 + 256 + 32 * s + 8 * kq));
            __builtin_amdgcn_sched_barrier(0);
#pragma unroll
            for (int rt = 0; rt < 2; ++rt) { float ss = 0.f;
#pragma unroll
                for (int s = 0; s < 4; ++s) { const u32x4 w = __builtin_bit_cast(u32x4, xf[rt][s]);
#pragma unroll
                    for (int e = 0; e < 4; ++e) { const float a = bf_lo(w[e]), b = bf_hi(w[e]); ss += a * a + b * b; } }
                ss += __shfl_xor(ss, 16); ss += __shfl_xor(ss, 32);
                rs[rt] = __builtin_amdgcn_rsqf(ss * (1.f / 128.f) + RMS_EPS); }
            asm volatile("s_waitcnt vmcnt(0)" ::: "memory"); __syncthreads();
#pragma unroll 1
            for (int npl = 0; npl < 8; ++npl) { const int np = 8 * (part - 2) + npl;
                bf16x8 W[4][2];
#pragma unroll
                for (int s_ = 0; s_ < 4; ++s_)
#pragma unroll
                    for (int nn = 0; nn < 2; ++nn) W[s_][nn] = *(const LAS bf16x8*)(lds + (32 * npl + 16 * nn + j16) * KP + 64 * s_ + 16 * kq);
                f32x4 acc[2][2];
#pragma unroll
                for (int a2 = 0; a2 < 2; ++a2)
#pragma unroll
                    for (int b2 = 0; b2 < 2; ++b2) acc[a2][b2] = (f32x4){0.f, 0.f, 0.f, 0.f};
#pragma unroll
                for (int s_ = 0; s_ < 4; ++s_)
#pragma unroll
                    for (int nn = 0; nn < 2; ++nn)
#pragma unroll
                        for (int rt = 0; rt < 2; ++rt) acc[rt][nn] = __builtin_amdgcn_mfma_f32_16x16x32_bf16(W[s_][nn], xf[rt][s_], acc[rt][nn], 0, 0, 0);
                const int n0 = 32 * np, h = n0 >> 7, within = n0 & 127;
#pragma unroll
                for (int rt = 0; rt < 2; ++rt) { const int tok = tok0 + 16 * rt + j16;
                    const f32x4 v0 = acc[rt][0] * rs[rt], v1 = acc[rt][1] * rs[rt];
                    u32x2 w0, w1; w0.x = pk2(v0[0], v0[1]); w0.y = pk2(v0[2], v0[3]); w1.x = pk2(v1[0], v1[1]); w1.y = pk2(v1[2], v1[3]);
                    bf16_t* dst = within < 64 ? KB + (size_t)tok * 384 + 96 * h + within : VB + (size_t)tok * 256 + 64 * h + (within - 64);
                    *(u32x2*)(dst + 4 * kq) = w0; *(u32x2*)(dst + 16 + 4 * kq) = w1; }
            }
            if (part == 3)
#pragma unroll
            for (int rt = 0; rt < 2; ++rt) { const int tok = tok0 + 16 * rt + j16;
                const u32x2 a = *(const u32x2*)(UB + (size_t)tok * 512 + 384 + 4 * kq), b = *(const u32x2*)(UB + (size_t)tok * 512 + 384 + 16 + 4 * kq);
                float x1[4] = {bf_lo(a.x), bf_hi(a.x), bf_lo(a.y), bf_hi(a.y)}, x2[4] = {bf_lo(b.x), bf_hi(b.x), bf_lo(b.y), bf_hi(b.y)};
                const f32x4* rp = (const f32x4*)(RB + (size_t)(tok & (T - 1)) * 16 + 4 * kq); const f32x4 c01 = rp[0], c23 = rp[1];
                float y1[4], y2[4];
#pragma unroll
                for (int e = 0; e < 4; ++e) { const float c = (e < 2 ? c01 : c23)[2 * (e & 1)], s = (e < 2 ? c01 : c23)[2 * (e & 1) + 1]; y1[e] = x1[e] * c - x2[e] * s; y2[e] = x2[e] * c + x1[e] * s; }
                u32x2 w0, w1; w0.x = pk2(y1[0], y1[1]); w0.y = pk2(y1[2], y1[3]); w1.x = pk2(y2[0], y2[1]); w1.y = pk2(y2[2], y2[3]);
#pragma unroll
                for (int h = 0; h < 4; ++h) { *(u32x2*)(KB + (size_t)tok * 384 + 96 * h + 64 + 4 * kq) = w0; *(u32x2*)(KB + (size_t)tok * 384 + 96 * h + 80 + 4 * kq) = w1; } }
        }
    }
    __syncthreads();
}

DI f32x16 mfma32(bf16x8 a, bf16x8 b, f32x16 c) { return __builtin_amdgcn_mfma_f32_32x32x16_bf16(a, b, c, 0, 0, 0); }
DI bf16x8 tr_pair(const LAS unsigned char* p0, const LAS unsigned char* p1) {
    const s16x4 lo = __builtin_amdgcn_ds_read_tr16_b64_v4i16((LAS s16x4*)p0), hi = __builtin_amdgcn_ds_read_tr16_b64_v4i16((LAS s16x4*)p1);
    return __builtin_shufflevector(lo, hi, 0, 1, 2, 3, 4, 5, 6, 7);
}
DI int crow(int i, int hh) { return (i & 3) + 8 * (i >> 2) + 4 * hh; }
constexpr float SM_THR = 8.f;
DI void softmax_step(f32x16& s, float& m, float& l, f32x16& O0, f32x16& O1, bf16x8& p0, bf16x8& p1) {
    float bm = s[0];
#pragma unroll
    for (int i = 1; i < 16; ++i) bm = fmaxf(bm, s[i]);
    bm = fmaxf(bm, __shfl_xor(bm, 32));
    if (!__all(bm <= m + SM_THR)) { const float mn = fmaxf(m, bm), al = __builtin_amdgcn_exp2f(m - mn); O0 = O0 * al; O1 = O1 * al; l *= al; m = mn; }
    float sum = 0.f;
#pragma unroll
    for (int i = 0; i < 16; ++i) { s[i] = __builtin_amdgcn_exp2f(s[i] - m); sum += s[i]; }
    l += sum;
    u32x4 a, b;
    a.x = pk2(s[0], s[1]); a.y = pk2(s[2], s[3]); a.z = pk2(s[4], s[5]); a.w = pk2(s[6], s[7]);
    b.x = pk2(s[8], s[9]); b.y = pk2(s[10], s[11]); b.z = pk2(s[12], s[13]); b.w = pk2(s[14], s[15]);
    p0 = __builtin_bit_cast(bf16x8, a); p1 = __builtin_bit_cast(bf16x8, b);
}
DI void softmax_local(f32x16& s, float& m, float& l, f32x16& O0, f32x16& O1, bf16x8& p0, bf16x8& p1) {
    float mx = fmaxf(fmaxf(s[0], s[1]), s[2]);
#pragma unroll
    for (int i = 3; i < 15; i += 2) mx = fmaxf(fmaxf(mx, s[i]), s[i + 1]);
    mx = fmaxf(mx, s[15]);
    if (__any(mx > m + SM_THR)) {
        mx = fmaxf(mx, __shfl_xor(mx, 32));
        const float mn = fmaxf(m, mx), al = __builtin_amdgcn_exp2f(m - mn); O0 = O0 * al; O1 = O1 * al; l *= al; m = mn; }
    float sum = 0.f;
#pragma unroll
    for (int i = 0; i < 16; ++i) { s[i] = __builtin_amdgcn_exp2f(s[i] - m); sum += s[i]; }
    l += sum;
    u32x4 a, b;
    a.x = pk2(s[0], s[1]); a.y = pk2(s[2], s[3]); a.z = pk2(s[4], s[5]); a.w = pk2(s[6], s[7]);
    b.x = pk2(s[8], s[9]); b.y = pk2(s[10], s[11]); b.z = pk2(s[12], s[13]); b.w = pk2(s[14], s[15]);
    p0 = __builtin_bit_cast(bf16x8, a); p1 = __builtin_bit_cast(bf16x8, b);
}
DI unsigned tr_lane_off(int lane) { const int i16 = lane & 15; return (unsigned)((4 * (lane >> 5) + (i16 >> 2)) * 64 + (16 * ((lane >> 4) & 1) + 4 * (i16 & 3)) * 2); }

template <bool QUANT>
DI void softmax_tile(f32x16& s0, f32x16& s1, float& m, float& l, f32x16& O0, f32x16& O1, bool first, bf16x8 (&pk)[4], f32x16& negm) {
    int mi = __float_as_int(s0[0]);
#pragma unroll
    for (int i = 1; i < 16; ++i) { const int a = __float_as_int(s0[i]); mi = mi > a ? mi : a; }
#pragma unroll
    for (int i = 0; i < 16; ++i) { const int a = __float_as_int(s1[i]); mi = mi > a ? mi : a; }
    if (first || __any(mi > 0x41000000  )) {
        float mx = fmaxf(s0[0], s1[0]);
#pragma unroll
        for (int i = 1; i < 16; ++i) mx = fmaxf(mx, fmaxf(s0[i], s1[i]));
        mx = fmaxf(mx, __shfl_xor(mx, 32));
        const float mraw = m + (first ? mx : fmaxf(mx, 0.f));
        const float mq = QUANT ? bf_lo(pk2(mraw, 0.f) & 0xffffu) : mraw;
        const float d = mq - m;
        const float al = first ? 1.f : __builtin_amdgcn_exp2f(-d);
        O0 = O0 * al; O1 = O1 * al; l *= al; m = mq;
#pragma unroll
        for (int i = 0; i < 16; ++i) { s0[i] -= d; s1[i] -= d; if (!QUANT) negm[i] = -mq; }
    }
    float sum = 0.f;
#pragma unroll
    for (int i = 0; i < 16; ++i) { s0[i] = __builtin_amdgcn_exp2f(s0[i]); s1[i] = __builtin_amdgcn_exp2f(s1[i]); sum += s0[i] + s1[i]; }
    l += sum;
    u32x4 a;
    a.x = pk2(s0[0], s0[1]); a.y = pk2(s0[2], s0[3]); a.z = pk2(s0[4], s0[5]); a.w = pk2(s0[6], s0[7]); pk[0] = __builtin_bit_cast(bf16x8, a);
    a.x = pk2(s0[8], s0[9]); a.y = pk2(s0[10], s0[11]); a.z = pk2(s0[12], s0[13]); a.w = pk2(s0[14], s0[15]); pk[1] = __builtin_bit_cast(bf16x8, a);
    a.x = pk2(s1[0], s1[1]); a.y = pk2(s1[2], s1[3]); a.z = pk2(s1[4], s1[5]); a.w = pk2(s1[6], s1[7]); pk[2] = __builtin_bit_cast(bf16x8, a);
    a.x = pk2(s1[8], s1[9]); a.y = pk2(s1[10], s1[11]); a.z = pk2(s1[12], s1[13]); a.w = pk2(s1[14], s1[15]); pk[3] = __builtin_bit_cast(bf16x8, a);
}
template <bool QUANT>
DI void softmax_check(f32x16& s0, f32x16& s1, float& m, float& l, f32x16& O0, f32x16& O1, bool first, f32x16& negm) {
    int mi = __float_as_int(s0[0]);
#pragma unroll
    for (int i = 1; i < 16; ++i) { const int a = __float_as_int(s0[i]); mi = mi > a ? mi : a; }
#pragma unroll
    for (int i = 0; i < 16; ++i) { const int a = __float_as_int(s1[i]); mi = mi > a ? mi : a; }
    if (first || __any(mi > 0x41000000  )) {
        float mx = fmaxf(s0[0], s1[0]);
#pragma unroll
        for (int i = 1; i < 16; ++i) mx = fmaxf(mx, fmaxf(s0[i], s1[i]));
        mx = fmaxf(mx, __shfl_xor(mx, 32));
        const float mraw = m + (first ? mx : fmaxf(mx, 0.f));
        const float mq = QUANT ? bf_lo(pk2(mraw, 0.f) & 0xffffu) : mraw;
        const float d = mq - m;
        const float al = first ? 1.f : __builtin_amdgcn_exp2f(-d);
        O0 = O0 * al; O1 = O1 * al; l *= al; m = mq;
#pragma unroll
        for (int i = 0; i < 16; ++i) { s0[i] -= d; s1[i] -= d; if (!QUANT) negm[i] = -mq; }
    }
}
#define ATT_EXP8(S, B, SUM, P) do { float e0_ = __builtin_amdgcn_exp2f(S[(B) + 0]), e1_ = __builtin_amdgcn_exp2f(S[(B) + 1]), e2_ = __builtin_amdgcn_exp2f(S[(B) + 2]), e3_ = __builtin_amdgcn_exp2f(S[(B) + 3]), \
        e4_ = __builtin_amdgcn_exp2f(S[(B) + 4]), e5_ = __builtin_amdgcn_exp2f(S[(B) + 5]), e6_ = __builtin_amdgcn_exp2f(S[(B) + 6]), e7_ = __builtin_amdgcn_exp2f(S[(B) + 7]); \
        SUM += ((e0_ + e1_) + (e2_ + e3_)) + ((e4_ + e5_) + (e6_ + e7_)); \
        u32x4 a_; a_.x = pk2(e0_, e1_); a_.y = pk2(e2_, e3_); a_.z = pk2(e4_, e5_); a_.w = pk2(e6_, e7_); P = __builtin_bit_cast(bf16x8, a_); } while (0)
#define ATT_SB __builtin_amdgcn_sched_barrier(0)
template <int MODE> struct AttSt {
    f32x16 Oa0, Oa1, Ob0, Ob1, sa0, sa1, nma; float ma, la, mb, lb; bf16x8 kone;
    const bf16_t* Kb; const bf16_t* Vb; unsigned ok0, ok1, ov;   int krs, wv; bool k2; unsigned xo[4]; unsigned troff; int hh;
};
#ifndef ATT_PRIO_ON
#define ATT_PRIO_ON 0
#endif
#define ATT_PRIO(x) do { if (ATT_PRIO_ON) __builtin_amdgcn_s_setprio(x); } while (0)
template <int MODE, int SC, int SN, int SP>
DI void att_tile(LAS unsigned char* lds, AttSt<MODE>& S, const bf16x8 (&q)[MODE == 0 ? 4 : 6], int j) {
    constexpr int DQ = MODE == 0 ? 64 : 96, KROW = DQ * 2, KBYTES = 64 * KROW, VBYTES = 8192, NQS = DQ / 16;
    const bool first = (j == 0);
    f32x16 zero16;
#pragma unroll
    for (int i = 0; i < 16; ++i) zero16[i] = 0.f;
    asm volatile("s_waitcnt vmcnt(0)" ::: "memory"); __builtin_amdgcn_s_barrier(); asm volatile("" ::: "memory");
    if (j + 2 < T / 64) { const size_t adv = (size_t)(j + 2) * 64;
        __builtin_amdgcn_global_load_lds((const unsigned*)((S.Kb + adv * S.krs) + S.ok0), (LAS unsigned*)(lds + SP * KBYTES + S.wv * 1024), 16, 0, 0);
        if (S.k2) __builtin_amdgcn_global_load_lds((const unsigned*)((S.Kb + adv * S.krs) + S.ok1), (LAS unsigned*)(lds + SP * KBYTES + (8 + S.wv) * 1024), 16, 0, 0);
        __builtin_amdgcn_global_load_lds((const unsigned*)((S.Vb + adv * 256) + S.ov), (LAS unsigned*)(lds + 3 * KBYTES + SP * VBYTES + S.wv * 1024), 16, 0, 0); }
    unsigned xo0 = S.xo[0]; asm volatile("" : "+v"(xo0));
#define ATT_KF(slot, blk, s) (*(const LAS bf16x8*)(lds + (slot) * KBYTES + (blk) * (32 * KROW) + (MODE == 0 ? (xo0 ^ ((unsigned)(s) << 5)) : (64 * ((s) >> 1) + S.xo[(s) & 1]))))
    const unsigned va_ = (unsigned)(size_t)lds + S.troff;
#define ATT_VLD(D0, D1, ks) do { s16x4 l0_, h0_, l1_, h1_; \
        asm volatile("ds_read_b64_tr_b16 %0, %4 offset:%5\n\tds_read_b64_tr_b16 %1, %4 offset:%6\n\tds_read_b64_tr_b16 %2, %4 offset:%7\n\tds_read_b64_tr_b16 %3, %4 offset:%8" \
                     : "=&v"(l0_), "=&v"(h0_), "=&v"(l1_), "=&v"(h1_) : "v"(va_), "n"(3 * KBYTES + SC * VBYTES + (16 * (ks)) * 64), "n"(3 * KBYTES + SC * VBYTES + (16 * (ks) + 8) * 64), \
                       "n"(3 * KBYTES + SC * VBYTES + 4096 + (16 * (ks)) * 64), "n"(3 * KBYTES + SC * VBYTES + 4096 + (16 * (ks) + 8) * 64) : "memory"); \
        D0 = __builtin_shufflevector(l0_, h0_, 0, 1, 2, 3, 4, 5, 6, 7); D1 = __builtin_shufflevector(l1_, h1_, 0, 1, 2, 3, 4, 5, 6, 7); } while (0)
#define ATT_VW2(a, b) asm volatile("s_waitcnt lgkmcnt(0)" : "+v"(a), "+v"(b) :: "memory")
#define ATT_VW8(a, b) asm volatile("s_waitcnt lgkmcnt(0)" : "+v"(a[0]), "+v"(a[1]), "+v"(a[2]), "+v"(a[3]), "+v"(b[0]), "+v"(b[1]), "+v"(b[2]), "+v"(b[3]) :: "memory")
    const int hh = S.hh;
    float sum = 0.f;
    if (MODE == 1) {
        bf16x8 vA0, vA1, vB0, vB1, pA, pB;
        bf16x8 kA0[2], kA1[2], kB0[2], kB1[2];
#pragma unroll
        for (int s = 0; s < 2; ++s) { kA0[s] = ATT_KF(SN, 0, s); kA1[s] = ATT_KF(SN, 1, s); }
        ATT_VLD(vA0, vA1, 0);
        softmax_check<false>(S.sa0, S.sa1, S.ma, S.la, S.Oa0, S.Oa1, first, S.nma);
        f32x16 sn0, sn1;
        ATT_SB;
#pragma unroll
        for (int s = 0; s < 2; ++s) { kB0[s] = ATT_KF(SN, 0, 2 + s); kB1[s] = ATT_KF(SN, 1, 2 + s); }
        sn0 = mfma32(kA0[0], q[0], S.nma); sn1 = mfma32(kA1[0], q[0], S.nma); sn0 = mfma32(kA0[1], q[1], sn0); sn1 = mfma32(kA1[1], q[1], sn1);
        ATT_EXP8(S.sa0, 0, sum, pA);
        ATT_SB;
#pragma unroll
        for (int s = 0; s < 2; ++s) { kA0[s] = ATT_KF(SN, 0, 4 + s); kA1[s] = ATT_KF(SN, 1, 4 + s); }
        ATT_VLD(vB0, vB1, 1);
        sn0 = mfma32(kB0[0], q[2], sn0); sn1 = mfma32(kB1[0], q[2], sn1); sn0 = mfma32(kB0[1], q[3], sn0); sn1 = mfma32(kB1[1], q[3], sn1);
        ATT_VW2(vA0, vA1); S.Oa0 = mfma32(vA0, pA, S.Oa0); S.Oa1 = mfma32(vA1, pA, S.Oa1);
        ATT_EXP8(S.sa0, 8, sum, pB);
        ATT_SB;
        ATT_VLD(vA0, vA1, 2);
        sn0 = mfma32(kA0[0], q[4], sn0); sn1 = mfma32(kA1[0], q[4], sn1); sn0 = mfma32(kA0[1], q[5], sn0); sn1 = mfma32(kA1[1], q[5], sn1);
        ATT_VW2(vB0, vB1); S.Oa0 = mfma32(vB0, pB, S.Oa0); S.Oa1 = mfma32(vB1, pB, S.Oa1);
        ATT_EXP8(S.sa1, 0, sum, pA);
        ATT_SB;
        ATT_VLD(vB0, vB1, 3);
        ATT_VW2(vA0, vA1); S.Oa0 = mfma32(vA0, pA, S.Oa0); S.Oa1 = mfma32(vA1, pA, S.Oa1);
        ATT_EXP8(S.sa1, 8, sum, pB);
        ATT_SB;
        ATT_VW2(vB0, vB1); S.Oa0 = mfma32(vB0, pB, S.Oa0); S.Oa1 = mfma32(vB1, pB, S.Oa1);
        S.la += sum; S.sa0 = sn0; S.sa1 = sn1;
    } else {
        bf16x8 pa[4];
        bf16x8 kf0[NQS], kf1[NQS];
#pragma unroll
        for (int s = 0; s < NQS; ++s) { kf0[s] = ATT_KF(SC, 0, s); kf1[s] = ATT_KF(SC, 1, s); }
        f32x16 sa0, sa1, sb0, sb1;
        const bf16x8 qxb = __builtin_bit_cast(bf16x8, (u32x4){hh ? 0u : (pk2(-S.mb, 0.f) & 0xffffu), 0u, 0u, 0u});
        ATT_PRIO(1);
        sb0 = mfma32(S.kone, qxb, zero16); asm volatile("" : "+v"(S.kone)); sb1 = mfma32(S.kone, qxb, zero16);
        ATT_SB;
        sa0 = mfma32(kf0[0], q[0], S.nma); sa1 = mfma32(kf1[0], q[0], S.nma); sb0 = mfma32(kf0[2], q[2], sb0); sb1 = mfma32(kf1[2], q[2], sb1);
        sa0 = mfma32(kf0[1], q[1], sa0); sa1 = mfma32(kf1[1], q[1], sa1); sb0 = mfma32(kf0[3], q[3], sb0); sb1 = mfma32(kf1[3], q[3], sb1);
        ATT_PRIO(0);
        ATT_SB;
        softmax_tile<false>(sa0, sa1, S.ma, S.la, S.Oa0, S.Oa1, first, pa, S.nma);
        ATT_SB;
        bf16x8 vf0[4], vf1[4];
#pragma unroll
        for (int ks = 0; ks < 4; ++ks) ATT_VLD(vf0[ks], vf1[ks], ks);
        ATT_VW8(vf0, vf1);
        ATT_PRIO(1);
#pragma unroll
        for (int ks = 0; ks < 4; ++ks) { S.Oa0 = mfma32(vf0[ks], pa[ks], S.Oa0); S.Oa1 = mfma32(vf1[ks], pa[ks], S.Oa1); }
        ATT_PRIO(0);
        softmax_tile<true>(sb0, sb1, S.mb, S.lb, S.Ob0, S.Ob1, first, pa, S.nma);
        ATT_SB;
        ATT_PRIO(1);
#pragma unroll
        for (int ks = 0; ks < 4; ++ks) { S.Ob0 = mfma32(vf0[ks], pa[ks], S.Ob0); S.Ob1 = mfma32(vf1[ks], pa[ks], S.Ob1); }
        ATT_PRIO(0);
    }
#undef ATT_VLD
#undef ATT_VW2
#undef ATT_VW8
}
template <int MODE, bool LATE>
DI void attn_full_unit(LAS unsigned char* lds, const bf16_t* Qg, const bf16_t* Kg, const bf16_t* Vg, int qrs, int krs, int seq0, int q0, bf16_t* outp,
                       float lam, float oscale, const float* subg, int tid) {
    constexpr int DQ = MODE == 0 ? 64 : 96, CPK = DQ / 8, KROW = DQ * 2, KBYTES = 64 * KROW, VBYTES = 8192, NQS = DQ / 16;
    const int lane = tid & 63, wave = tid >> 6, r = lane & 31, hh = lane >> 5;
    bf16x8 q[NQS];
    { const bf16_t* qp = Qg + (size_t)(seq0 + q0 + 32 * wave + r) * qrs + 8 * hh;
#pragma unroll
      for (int s = 0; s < NQS; ++s) q[s] = *(const bf16x8*)(qp + 16 * s); }
    AttSt<MODE> S;
    S.ma = 0.f; S.la = 0.f; S.mb = 0.f; S.lb = 0.f; S.hh = hh; S.krs = krs;
#pragma unroll
    for (int i = 0; i < 16; ++i) { S.Oa0[i] = 0.f; S.Oa1[i] = 0.f; S.Ob0[i] = 0.f; S.Ob1[i] = 0.f; S.sa0[i] = 0.f; S.sa1[i] = 0.f; S.nma[i] = 0.f; }
    S.kone = __builtin_bit_cast(bf16x8, (u32x4){hh ? 0u : 0x3f80u, 0u, 0u, 0u});
    const int wv = __builtin_amdgcn_readfirstlane(wave);
    const int c0 = 64 * wv + lane, key0 = c0 / CPK, sl0 = c0 % CPK, pt0 = MODE == 0 ? (sl0 ^ ((key0 >> 1) & 7)) : ((sl0 & ~3) | ((sl0 & 3) ^ ((key0 >> 2) & 3)));
    const int c1 = 64 * (8 + wv) + lane, key1 = c1 / CPK, sl1 = c1 % CPK, pt1 = (sl1 & ~3) | ((sl1 & 3) ^ ((key1 >> 2) & 3));
    S.wv = wv; S.k2 = (MODE == 1) && wv < 4;
    S.Kb = Kg + (size_t)seq0 * krs; S.ok0 = (unsigned)(key0 * krs + 8 * pt0); S.ok1 = (unsigned)((S.k2 ? key1 : 0) * krs + 8 * pt1);
    S.Vb = Vg + (size_t)seq0 * 256; S.ov = (unsigned)((16 * (wv & 3) + (lane >> 2)) * 256 + 8 * (4 * (wv >> 2) + (lane & 3)));
    S.troff = tr_lane_off(lane);
    if (MODE == 0) {
#pragma unroll
        for (int pp = 0; pp < 4; ++pp) S.xo[pp] = (unsigned)(r * KROW + (((2 * pp + hh) ^ ((r >> 1) & 7)) << 4));
    } else {
#pragma unroll
        for (int e = 0; e < 2; ++e) S.xo[e] = (unsigned)(r * KROW + (((2 * e + hh) ^ ((r >> 2) & 3)) << 4));
        S.xo[2] = 0; S.xo[3] = 0;
    }
#pragma unroll
    for (int t0 = 0; t0 < 2; ++t0) { const size_t adv = (size_t)t0 * 64;
        __builtin_amdgcn_global_load_lds((const unsigned*)((S.Kb + adv * krs) + S.ok0), (LAS unsigned*)(lds + t0 * KBYTES + wv * 1024), 16, 0, 0);
        if (S.k2) __builtin_amdgcn_global_load_lds((const unsigned*)((S.Kb + adv * krs) + S.ok1), (LAS unsigned*)(lds + t0 * KBYTES + (8 + wv) * 1024), 16, 0, 0);
        __builtin_amdgcn_global_load_lds((const unsigned*)((S.Vb + adv * 256) + S.ov), (LAS unsigned*)(lds + 3 * KBYTES + t0 * VBYTES + wv * 1024), 16, 0, 0); }
    asm volatile("s_waitcnt vmcnt(0)" ::: "memory");
    __syncthreads();
    const unsigned xo0 = S.xo[0];
    if (MODE == 1) {
        f32x16 zero16;
#pragma unroll
        for (int i = 0; i < 16; ++i) zero16[i] = 0.f;
        S.sa0 = mfma32(ATT_KF(0, 0, 0), q[0], zero16); S.sa1 = mfma32(ATT_KF(0, 1, 0), q[0], zero16);
#pragma unroll
        for (int s = 1; s < NQS; ++s) { S.sa0 = mfma32(ATT_KF(0, 0, s), q[s], S.sa0); S.sa1 = mfma32(ATT_KF(0, 1, s), q[s], S.sa1); } }
    for (int j = 0; j < T / 64; j += 3) {
        att_tile<MODE, 0, 1, 2>(lds, S, q, j);
        if (j + 1 < T / 64) att_tile<MODE, 1, 2, 0>(lds, S, q, j + 1);
        if (j + 2 < T / 64) att_tile<MODE, 2, 0, 1>(lds, S, q, j + 2);
    }
#undef ATT_KF
    __syncthreads();
    f32x16& Oa0 = S.Oa0; f32x16& Oa1 = S.Oa1; f32x16& Ob0 = S.Ob0; f32x16& Ob1 = S.Ob1; const float la = S.la, lb = S.lb;
    int tid_e = tid; asm volatile("" : "+v"(tid_e));
    const int lane_e = tid_e & 63, hh_e = lane_e >> 5;
    const float lat = la + __shfl_xor(la, 32);
    bf16_t* orow = outp + (size_t)(seq0 + q0 + 32 * (tid_e >> 6) + (lane_e & 31)) * D + 4 * hh_e;
    if (MODE == 0) {
        const float lbt = lb + __shfl_xor(lb, 32);
        const float ia = 1.f / lat, ib = lam / lbt; float ss = 0.f;
#pragma unroll
        for (int i = 0; i < 16; ++i) { Oa0[i] = Oa0[i] * ia - Ob0[i] * ib; Oa1[i] = Oa1[i] * ia - Ob1[i] * ib; ss += Oa0[i] * Oa0[i] + Oa1[i] * Oa1[i]; }
        ss += __shfl_xor(ss, 32);
        const float rsn = __builtin_amdgcn_rsqf(ss * (1.f / 64.f) + RMS_EPS) * oscale;
#pragma unroll
        for (int g4 = 0; g4 < 4; ++g4) { const f32x4 g0 = *(const f32x4*)(subg + 8 * g4 + 4 * hh_e), g1 = *(const f32x4*)(subg + 32 + 8 * g4 + 4 * hh_e);
            u32x2 w0, w1;
            w0.x = pk2(Oa0[4 * g4] * rsn * g0[0], Oa0[4 * g4 + 1] * rsn * g0[1]); w0.y = pk2(Oa0[4 * g4 + 2] * rsn * g0[2], Oa0[4 * g4 + 3] * rsn * g0[3]);
            w1.x = pk2(Oa1[4 * g4] * rsn * g1[0], Oa1[4 * g4 + 1] * rsn * g1[1]); w1.y = pk2(Oa1[4 * g4 + 2] * rsn * g1[2], Oa1[4 * g4 + 3] * rsn * g1[3]);
            *(u32x2*)(orow + 8 * g4) = w0; *(u32x2*)(orow + 32 + 8 * g4) = w1; }
    } else {
        const float ia = 1.f / lat;
#pragma unroll
        for (int g4 = 0; g4 < 4; ++g4) { u32x2 w0, w1;
            w0.x = pk2(Oa0[4 * g4] * ia, Oa0[4 * g4 + 1] * ia); w0.y = pk2(Oa0[4 * g4 + 2] * ia, Oa0[4 * g4 + 3] * ia);
            w1.x = pk2(Oa1[4 * g4] * ia, Oa1[4 * g4 + 1] * ia); w1.y = pk2(Oa1[4 * g4 + 2] * ia, Oa1[4 * g4 + 3] * ia);
            *(u32x2*)(orow + 8 * g4) = w0; *(u32x2*)(orow + 32 + 8 * g4) = w1; }
    }
}

struct LocalRegs { u32x4 kv[4], vv[4]; };
DI void local_issue(const bf16_t* Kh, const bf16_t* Vh, int seq0, int kpos0, int kstride, int lane, LocalRegs& R) {
#pragma unroll
    for (int i = 0; i < 4; ++i) { const int c = lane + 64 * i, key = c >> 3, part = c & 7; int pk = kpos0 + kstride * key; pk = pk < 0 ? 0 : (pk > T - 1 ? T - 1 : pk);
        R.kv[i] = *(const u32x4*)(Kh + (size_t)(seq0 + pk) * 256 + 8 * part); R.vv[i] = *(const u32x4*)(Vh + (size_t)(seq0 + pk) * 256 + 8 * part); }
}
DI void local_commit(LAS unsigned char* wl, int lane, const LocalRegs& R) {
    LDS_WAIT();
#pragma unroll
    for (int i = 0; i < 4; ++i) { const int c = lane + 64 * i, key = c >> 3, part = c & 7;
        *(LAS u32x4*)(wl + key * 144 + part * 16) = R.kv[i]; *(LAS u32x4*)(wl + 4608 + (part >> 2) * 2048 + key * 64 + (part & 3) * 16) = R.vv[i]; }
    LDS_WAIT();
}
DI f32x16 local_qk(const LAS unsigned char* wl, const bf16x8 (&q)[4], int r, int hh) {
    f32x16 s;
#pragma unroll
    for (int i = 0; i < 16; ++i) s[i] = 0.f;
    const LAS unsigned char* kr = wl + r * 144 + 16 * hh;
#pragma unroll
    for (int st = 0; st < 4; ++st) s = mfma32(*(const LAS bf16x8*)(kr + 32 * st), q[st], s);
    return s;
}
DI void local_pv(const LAS unsigned char* wl, unsigned troff, bf16x8 p0, bf16x8 p1, f32x16& O0, f32x16& O1) {
    const LAS unsigned char* vr = wl + 4608 + troff;
#pragma unroll
    for (int s = 0; s < 2; ++s) {
        const bf16x8 v0 = tr_pair(vr + (16 * s) * 64, vr + (16 * s + 8) * 64), v1 = tr_pair(vr + 2048 + (16 * s) * 64, vr + 2048 + (16 * s + 8) * 64);
        O0 = mfma32(v0, s ? p1 : p0, O0); O1 = mfma32(v1, s ? p1 : p0, O1); }
}
DI void local_store(bf16_t* orow  , const f32x16& O0, const f32x16& O1, float l) {
    const float ia = 1.f / (l + __shfl_xor(l, 32));
#pragma unroll
    for (int g4 = 0; g4 < 4; ++g4) { u32x2 w0, w1;
        w0.x = pk2(O0[4 * g4] * ia, O0[4 * g4 + 1] * ia); w0.y = pk2(O0[4 * g4 + 2] * ia, O0[4 * g4 + 3] * ia);
        w1.x = pk2(O1[4 * g4] * ia, O1[4 * g4 + 1] * ia); w1.y = pk2(O1[4 * g4 + 2] * ia, O1[4 * g4 + 3] * ia);
        *(u32x2*)(orow + 8 * g4) = w0; *(u32x2*)(orow + 32 + 8 * g4) = w1; }
}

DI void local_dma(const bf16_t* Kh, const bf16_t* Vh, int seq0, int kpos0, int kstride, LAS unsigned char* buf  , int lane) {
#pragma unroll
    for (int j = 0; j < 4; ++j) { const int c = 64 * j + lane, key = c >> 3, part = (c & 7) ^ ((key >> 1) & 7); int pk = kpos0 + kstride * key; pk = pk < 0 ? 0 : (pk > T - 1 ? T - 1 : pk);
        __builtin_amdgcn_global_load_lds((const unsigned*)(Kh + (size_t)(seq0 + pk) * 256 + 8 * part), (LAS unsigned*)(buf + j * 1024), 16, 0, 0); }
#pragma unroll
    for (int j = 0; j < 4; ++j) { const int key = 16 * (j & 1) + (lane >> 2), part = 4 * (j >> 1) + (lane & 3); int pk = kpos0 + kstride * key; pk = pk < 0 ? 0 : (pk > T - 1 ? T - 1 : pk);
        __builtin_amdgcn_global_load_lds((const unsigned*)(Vh + (size_t)(seq0 + pk) * 256 + 8 * part), (LAS unsigned*)(buf + 4096 + j * 1024), 16, 0, 0); }
}
#define LQ_DSR(dst, addr, off) asm volatile("ds_read_b128 %0, %1 offset:%2" : "=v"(dst) : "v"(addr), "n"(off) : "memory")
#define LQ_WAIT(N, reg) asm volatile("s_waitcnt lgkmcnt(" #N ")" : "+v"(reg) :: "memory")
template <int B>
DI void local_kread(unsigned ka0, bf16x8 (&k)[4]) {
    asm volatile("" : "+v"(ka0)); const unsigned a1 = ka0 ^ 32u, a2 = ka0 ^ 64u, a3 = ka0 ^ 96u;
    LQ_DSR(k[0], ka0, B * 8192); LQ_DSR(k[1], a1, B * 8192); LQ_DSR(k[2], a2, B * 8192); LQ_DSR(k[3], a3, B * 8192); }
template <int NB>
DI f32x16 local_qk3(bf16x8 (&k)[4], const bf16x8 (&q)[4]) {
    f32x16 s;
#pragma unroll
    for (int i = 0; i < 16; ++i) s[i] = 0.f;
    if constexpr (NB == 0) { LQ_WAIT(3, k[0]); s = mfma32(k[0], q[0], s); LQ_WAIT(2, k[1]); s = mfma32(k[1], q[1], s); LQ_WAIT(1, k[2]); s = mfma32(k[2], q[2], s); LQ_WAIT(0, k[3]); s = mfma32(k[3], q[3], s); }
    else { static_assert(NB == 8, "NB"); LQ_WAIT(11, k[0]); s = mfma32(k[0], q[0], s); LQ_WAIT(10, k[1]); s = mfma32(k[1], q[1], s); LQ_WAIT(9, k[2]); s = mfma32(k[2], q[2], s); LQ_WAIT(8, k[3]); s = mfma32(k[3], q[3], s); }
    return s;
}
template <int B>
DI void local_pv2(unsigned va  , bf16x8 p0, bf16x8 p1, f32x16& O0, f32x16& O1) {
    s16x4 a0, a1, a2, a3, b0, b1, b2, b3;
    asm volatile("ds_read_b64_tr_b16 %0, %8 offset:%9\n\tds_read_b64_tr_b16 %1, %8 offset:%10\n\tds_read_b64_tr_b16 %2, %8 offset:%11\n\tds_read_b64_tr_b16 %3, %8 offset:%12\n\t"
                 "ds_read_b64_tr_b16 %4, %8 offset:%13\n\tds_read_b64_tr_b16 %5, %8 offset:%14\n\tds_read_b64_tr_b16 %6, %8 offset:%15\n\tds_read_b64_tr_b16 %7, %8 offset:%16\n\ts_waitcnt lgkmcnt(0)"
                 : "=&v"(a0), "=&v"(a1), "=&v"(a2), "=&v"(a3), "=&v"(b0), "=&v"(b1), "=&v"(b2), "=&v"(b3)
                 : "v"(va), "n"(B * 8192 + 4096), "n"(B * 8192 + 4096 + 512), "n"(B * 8192 + 4096 + 2048), "n"(B * 8192 + 4096 + 2048 + 512),
                   "n"(B * 8192 + 4096 + 1024), "n"(B * 8192 + 4096 + 1024 + 512), "n"(B * 8192 + 4096 + 2048 + 1024), "n"(B * 8192 + 4096 + 2048 + 1024 + 512) : "memory");
    const bf16x8 v00 = __builtin_shufflevector(a0, a1, 0, 1, 2, 3, 4, 5, 6, 7), v01 = __builtin_shufflevector(a2, a3, 0, 1, 2, 3, 4, 5, 6, 7);
    const bf16x8 v10 = __builtin_shufflevector(b0, b1, 0, 1, 2, 3, 4, 5, 6, 7), v11 = __builtin_shufflevector(b2, b3, 0, 1, 2, 3, 4, 5, 6, 7);
    O0 = mfma32(v00, p0, O0); O1 = mfma32(v01, p0, O1); O0 = mfma32(v10, p1, O0); O1 = mfma32(v11, p1, O1);
}
constexpr int ATT_RPB_OFF = RING_BYTES + 1024;

DI void attn_phase(CParams p, int l, LAS unsigned char* lds, int tid_in, int wg, int G) {
    int tid = tid_in;
    int lane = tid & 63, wave = tid >> 6;
    const bf16_t* U = (const bf16_t*)(p->ws + WS_U); const size_t US = (size_t)M * 256;
    bf16_t* CAT = (bf16_t*)(p->ws + WS_CAT);
    float lam;
    { float a = 0.f, b = 0.f; if (lane < 32) { a = p->in[9][l * 32 + lane] * p->in[10][l * 32 + lane]; b = p->in[11][l * 32 + lane] * p->in[12][l * 32 + lane]; }
      a = wave_sum(a); b = wave_sum(b); lam = __expf(a) - __expf(b) + p->lam_init[l];
      lam = __builtin_bit_cast(float, __builtin_amdgcn_readfirstlane(__builtin_bit_cast(int, lam))); }
    const float oscale = 1.f - p->lam_init[l];
#ifndef ATT_PHASE_SHIFT
#define ATT_PHASE_SHIFT 0
#endif
#ifndef ATT_LATE_OF
#define ATT_LATE_OF(w) ((w) & 1)
#endif
    const bool late_wave = ATT_PHASE_SHIFT && ATT_LATE_OF(__builtin_amdgcn_readfirstlane(wave));
    { LAS float* bt = (LAS float*)(lds + ATT_RPB_OFF); for (int i = tid; i < 4 * 15 * 31 + 128; i += 512) { const int j = i - 64; bt[i] = (j >= 0 && j < 4 * 15 * 31) ? p->in[14][(size_t)l * 4 * 15 * 31 + j] * LOG2E : 0.f; } }
    __syncthreads();
#ifndef ATT_DUP
#define ATT_DUP 0
#endif
#ifndef ATT_SKIP
#define ATT_SKIP 0
#endif
    if (!(ATT_SKIP & 1))
    for (int rep_ = 0, nrep_ = (ATT_DUP & 1) ? opaque_int(2) : 1; rep_ < nrep_; ++rep_)
    for (int i = 0; i < (NSEQ * 4 * 16 + G - 1) / G; ++i) {
        int bh, qb;
        if (G == 256) { const int x = wg & 7, y = wg >> 3; bh = i * 16 + 2 * x + (y >> 4); qb = y & 15; } else { const int u = i * G + wg; bh = u >> 4; qb = u & 15; }
        if (bh >= NSEQ * 4) break;
        const int b = bh >> 2, h = bh & 3;
        asm volatile("" : "+v"(tid));
        if (late_wave) attn_full_unit<0, true>(lds, U + 0 * US + 64 * h, U + 1 * US + 64 * h, U + 2 * US + 64 * h, 256, 256, b * T, qb * 256, CAT + 64 * h, lam, oscale, p->in[13] + l * 64, tid);
        else attn_full_unit<0, false>(lds, U + 0 * US + 64 * h, U + 1 * US + 64 * h, U + 2 * US + 64 * h, 256, 256, b * T, qb * 256, CAT + 64 * h, lam, oscale, p->in[13] + l * 64, tid);
    }
    if (!(ATT_SKIP & 2))
    for (int rep_ = 0, nrep_ = (ATT_DUP & 2) ? opaque_int(2) : 1; rep_ < nrep_; ++rep_)
    for (int i = 0; i < (NSEQ * 4 * 16 + G - 1) / G; ++i) {
        int bh, qb;
        if (G == 256) { const int x = wg & 7, y = wg >> 3; bh = i * 16 + 2 * x + (y >> 4); qb = y & 15; } else { const int u = i * G + wg; bh = u >> 4; qb = u & 15; }
        if (bh >= NSEQ * 4) break;
        const int b = bh >> 2, h = bh & 3;
        asm volatile("" : "+v"(tid));
        if (late_wave) attn_full_unit<1, true>(lds, (const bf16_t*)(p->ws + WS_QB) + 96 * h, (const bf16_t*)(p->ws + WS_KB) + 96 * h, (const bf16_t*)(p->ws + WS_VB) + 64 * h, 384, 384, b * T, qb * 256, CAT + 256 + 64 * h, 0.f, 1.f, nullptr, tid);
        else attn_full_unit<1, false>(lds, (const bf16_t*)(p->ws + WS_QB) + 96 * h, (const bf16_t*)(p->ws + WS_KB) + 96 * h, (const bf16_t*)(p->ws + WS_VB) + 64 * h, 384, 384, b * T, qb * 256, CAT + 256 + 64 * h, 0.f, 1.f, nullptr, tid);
    }
    asm volatile("" : "+v"(tid));
    lane = tid & 63; wave = tid >> 6; const int r = lane & 31, hh = lane >> 5;
    LAS unsigned char* wl = lds + __builtin_amdgcn_readfirstlane(wave) * 16384;
    const unsigned va = (unsigned)(size_t)wl + tr_lane_off(lane);
    unsigned xo[4];
#pragma unroll
    for (int st = 0; st < 4; ++st) xo[st] = (unsigned)(r * 128 + (((2 * st + hh) ^ ((r >> 1) & 7)) << 4));
    const unsigned ka = (unsigned)(size_t)wl + xo[0];
    __syncthreads();
    const bool conv_first = __builtin_amdgcn_readfirstlane(wave) < 4;
#define LB_BLOCK(B, KPOS0, DIL, NEXT) { const int kpos0 = (KPOS0); const int dil = (DIL), halfw = 64 * dil; \
            NEXT \
            bf16x8 kf[4]; local_kread<B>(ka, kf); f32x16 s = local_qk3<0>(kf, q); \
            const int tb = kpos0 - pq + halfw + 4 * dil * hh;                   \
            const bool edge = kpos0 < 0 || kpos0 + 31 * dil >= T;                \
            if (!edge) { \
                _Pragma("unroll") for (int i = 0; i < 16; ++i) { const unsigned t = (unsigned)(tb + dil * ((i & 3) + 8 * (i >> 2))); s[i] = s[i] + (t <= 2u * (unsigned)halfw ? 0.f : -INFINITY); } \
            } else { \
                _Pragma("unroll") for (int i = 0; i < 16; ++i) { const int t = tb + dil * ((i & 3) + 8 * (i >> 2)); const unsigned pk = (unsigned)(t - halfw + pq); \
                    s[i] = s[i] + (((unsigned)t <= 2u * (unsigned)halfw && pk < (unsigned)T) ? 0.f : -INFINITY); } \
            } \
            bf16x8 p0, p1; softmax_local(s, m, lsum, O0, O1, p0, p1); \
            local_pv2<B>(va, p0, p1, O0, O1); }
#define LB_NEXT(B, KPOS0, DIL) { local_dma(Kh, Vh, seq0, (KPOS0), (DIL), wl + (1 - B) * 8192, lane); asm volatile("s_waitcnt vmcnt(8)" ::: "memory"); }
#define LB_LAST asm volatile("s_waitcnt vmcnt(0)" ::: "memory");
    float* REC = (float*)((unsigned char*)p->out + (size_t)M * D * 2);
    f32x2* RML = (f32x2*)(REC + (size_t)M * 4 * 2 * 32);
    const bf16_t* Dk = U + 7 * US; const bf16_t* Dv = U + 8 * US;
    const LAS float* bt = (const LAS float*)(lds + ATT_RPB_OFF);
    for (int stage = 0; stage < 3; ++stage) {
    const int what = stage == 0 ? 1 : (((stage == 1) == conv_first) ? 0 : 2);
    if (what == 0) {
        convert_experts_wave(p, l, wl, G > 2 * NE ? CONV_EARLY : 0, CONV_JOBS_PER_LAYER, wg * NWAVES + __builtin_amdgcn_readfirstlane(wave), G * NWAVES, lane);
    } else if (what == 1) {
    for (int rep_ = 0, nrep_ = (ATT_DUP & 4) ? opaque_int(2) : 1; rep_ < nrep_; ++rep_)
    for (int g = wg; g < NSEQ * 4 * 8; g += G) {
        const int blk = g & 7, bh = g >> 3, b = bh >> 2, h = bh & 3, seq0 = b * T;
        const bf16_t* Kh = U + 4 * US + 64 * h; const bf16_t* Vh = U + 5 * US + 64 * h;
#pragma unroll 1
        for (int s2 = 0; s2 < 2; ++s2) {
            const int r16 = 2 * __builtin_amdgcn_readfirstlane(wave) + s2, pq = blk * 512 + 16 * r + r16, k0 = blk * 512 + r16 - 1024;
            local_dma(Kh, Vh, seq0, k0, 16, wl, lane);
            bf16x8 q[4];
            { const bf16_t* qp = U + 3 * US + (size_t)(seq0 + pq) * 256 + 64 * h + 8 * hh;
#pragma unroll
              for (int s = 0; s < 4; ++s) q[s] = *(const bf16x8*)(qp + 16 * s); }
            f32x16 O0, O1; float m = -1e30f, lsum = 0.f;
#pragma unroll
            for (int i = 0; i < 16; ++i) { O0[i] = 0.f; O1[i] = 0.f; }
            LB_BLOCK(0, k0, 16, LB_NEXT(0, k0 + 512, 16)) LB_BLOCK(1, k0 + 512, 16, LB_NEXT(1, k0 + 1024, 16)) LB_BLOCK(0, k0 + 1024, 16, LB_NEXT(0, k0 + 1536, 16)) LB_BLOCK(1, k0 + 1536, 16, LB_NEXT(1, k0 + 2048, 16)) LB_BLOCK(0, k0 + 2048, 16, LB_LAST)
            float* rec = REC + ((((size_t)(seq0 + pq)) * 4 + h) * 2 + hh) * 32;
#pragma unroll
            for (int g4 = 0; g4 < 4; ++g4) { *(f32x4*)(rec + 4 * g4) = (f32x4){O0[4 * g4], O0[4 * g4 + 1], O0[4 * g4 + 2], O0[4 * g4 + 3]}; *(f32x4*)(rec + 16 + 4 * g4) = (f32x4){O1[4 * g4], O1[4 * g4 + 1], O1[4 * g4 + 2], O1[4 * g4 + 3]}; }
            RML[(((size_t)(seq0 + pq)) * 4 + h) * 2 + hh] = (f32x2){m, lsum};
        }
        __builtin_amdgcn_fence(__ATOMIC_RELEASE, "workgroup"); __syncthreads(); __builtin_amdgcn_fence(__ATOMIC_ACQUIRE, "workgroup");
#pragma unroll 1
        for (int s2 = 0; s2 < 2; ++s2) {
            const int qi = 2 * __builtin_amdgcn_readfirstlane(wave) + s2, b128 = blk * 512 + 128 * (qi >> 2), r4 = qi & 3, pq = b128 + 4 * r + r4, k1 = b128 + r4 - 64, k4 = b128 + r4 - 256;
            local_dma(Kh, Vh, seq0, k1, 1, wl, lane);
            bf16x8 q[4];
            { const bf16_t* qp = U + 3 * US + (size_t)(seq0 + pq) * 256 + 64 * h + 8 * hh;
#pragma unroll
              for (int s = 0; s < 4; ++s) q[s] = *(const bf16x8*)(qp + 16 * s); }
            f32x16 O0, O1; float m = -1e30f, lsum = 0.f;
#pragma unroll
            for (int i = 0; i < 16; ++i) { O0[i] = 0.f; O1[i] = 0.f; }
#define P2_KPOS(i_) ((i_) < 8 ? k1 + 32 * (i_) : k4 + 128 * ((i_) - 8))
#define P2_DIL(i_) ((i_) < 8 ? 1 : 4)
#pragma unroll 1
            for (int i2 = 0; i2 < 12; i2 += 2) { LB_BLOCK(0, P2_KPOS(i2), P2_DIL(i2), LB_NEXT(0, P2_KPOS(i2 + 1), P2_DIL(i2 + 1))) LB_BLOCK(1, P2_KPOS(i2 + 1), P2_DIL(i2 + 1), LB_NEXT(1, P2_KPOS(i2 + 2), P2_DIL(i2 + 2))) }
            f32x4 ro[8]; f32x2 rml;
            { const float* rec = REC + ((((size_t)(seq0 + pq)) * 4 + h) * 2 + hh) * 32;
#pragma unroll
              for (int g4 = 0; g4 < 8; ++g4) ro[g4] = *(const f32x4*)(rec + 4 * g4);
              rml = RML[(((size_t)(seq0 + pq)) * 4 + h) * 2 + hh]; }
            LB_BLOCK(0, k4 + 512, 4, asm volatile("s_waitcnt vmcnt(9)" ::: "memory");)
#undef P2_KPOS
#undef P2_DIL
            { const float mm = fmaxf(m, rml.x), a2 = __builtin_amdgcn_exp2f(m - mm), a16 = __builtin_amdgcn_exp2f(rml.x - mm);
              lsum = lsum * a2 + rml.y * a16;
#pragma unroll
              for (int i = 0; i < 16; ++i) { O0[i] = O0[i] * a2 + ro[i >> 2][i & 3] * a16; O1[i] = O1[i] * a2 + ro[4 + (i >> 2)][i & 3] * a16; } }
            local_store(CAT + (size_t)(seq0 + pq) * D + 512 + 64 * h + 4 * hh, O0, O1, lsum);
        }
    }
    } else {
#define D_BLOCK(B, N) { const int n = (N); const int krow = rs0 + n; \
            if (n + 1 < 9) { local_dma(Kh, Vh, seq0, (krow + 1) * 64 + kc0, 1, wl + (1 - B) * 8192, lane); asm volatile("s_waitcnt vmcnt(8)" ::: "memory"); } \
            else asm volatile("s_waitcnt vmcnt(0)" ::: "memory"); \
            bf16x8 kf[4]; local_kread<B>(ka, kf); \
            const unsigned ba = (unsigned)(size_t)bt + 4u * (unsigned)(64 + (h * 15 + (krow - qrow + 7)) * 31 + (kc0 + 4 * hh - qcol + 15));        \
            f32x2 bv[8]; \
            asm volatile("ds_read2_b32 %0, %8 offset1:1\n\tds_read2_b32 %1, %8 offset0:2 offset1:3\n\tds_read2_b32 %2, %8 offset0:8 offset1:9\n\tds_read2_b32 %3, %8 offset0:10 offset1:11\n\t" \
                         "ds_read2_b32 %4, %8 offset0:16 offset1:17\n\tds_read2_b32 %5, %8 offset0:18 offset1:19\n\tds_read2_b32 %6, %8 offset0:24 offset1:25\n\tds_read2_b32 %7, %8 offset0:26 offset1:27" \
                         : "=&v"(bv[0]), "=&v"(bv[1]), "=&v"(bv[2]), "=&v"(bv[3]), "=&v"(bv[4]), "=&v"(bv[5]), "=&v"(bv[6]), "=&v"(bv[7]) : "v"(ba) : "memory"); \
            f32x16 s = local_qk3<8>(kf, q); \
            asm volatile("s_waitcnt lgkmcnt(0)" : "+v"(bv[0]), "+v"(bv[1]), "+v"(bv[2]), "+v"(bv[3]), "+v"(bv[4]), "+v"(bv[5]), "+v"(bv[6]), "+v"(bv[7]) :: "memory"); \
            const float rm = ((unsigned)(krow - rsq) < 8u) ? 0.f : -INFINITY;               \
            _Pragma("unroll") for (int i = 0; i < 16; ++i) s[i] = (s[i] + bv[2 * (i >> 2) + ((i & 3) >> 1)][i & 1]) + (nm[i] + rm); \
            bf16x8 p0, p1; softmax_local(s, m, lsum, O0, O1, p0, p1); \
            local_pv2<B>(va, p0, p1, O0, O1); }
    int d0, d1, dstep;
    if (G == 256) { const int db = wg < 128 ? 28 * wg : 3584 + 52 * (wg - 128); d0 = db + wave; d1 = db + (wg < 128 ? 28 : 52); dstep = NWAVES; }
    else { d0 = wg * NWAVES + wave; d1 = NSEQ * 4 * 32 * 4; dstep = G * NWAVES; }
    for (int rep_ = 0, nrep_ = (ATT_DUP & 8) ? opaque_int(2) : 1; rep_ < nrep_; ++rep_)
    for (int task = d0; task < d1; task += dstep) {
        const int cb = task & 3, rp = (task >> 2) & 31, bh = task >> 7, b = bh >> 2, h = bh & 3, seq0 = b * T;
        const int qrow = 2 * rp + ((r >> 4) & 1), qcol = 16 * cb + (r & 15), pq = qrow * 64 + qcol;
        const bf16_t* Kh = Dk + 64 * h; const bf16_t* Vh = Dv + 64 * h;
        const int rs0 = 2 * rp - 4 < 0 ? 0 : (2 * rp - 4 > 56 ? 56 : 2 * rp - 4);
        const int kc0 = 16 * cb - 8 < 0 ? 0 : (16 * cb - 8 > 32 ? 32 : 16 * cb - 8);
        local_dma(Kh, Vh, seq0, rs0 * 64 + kc0, 1, wl, lane);
        bf16x8 q[4];
        { const bf16_t* qp = U + 6 * US + (size_t)(seq0 + pq) * 256 + 64 * h + 8 * hh;
#pragma unroll
          for (int s = 0; s < 4; ++s) q[s] = *(const bf16x8*)(qp + 16 * s); }
        f32x16 O0, O1; float m = -1e30f, lsum = 0.f;
#pragma unroll
        for (int i = 0; i < 16; ++i) { O0[i] = 0.f; O1[i] = 0.f; }
        const int rsq = qrow - 4 < 0 ? 0 : (qrow - 4 > 56 ? 56 : qrow - 4);
        const int cs = qcol - 8 < 0 ? 0 : (qcol - 8 > 48 ? 48 : qcol - 8);
        f32x16 nm;
#pragma unroll
        for (int i = 0; i < 16; ++i) { const int kc = kc0 + crow(i, hh); nm[i] = (kc >= cs && kc < cs + 16) ? 0.f : -INFINITY; }
#pragma unroll 1
        for (int n2 = 0; n2 < 8; n2 += 2) { D_BLOCK(0, n2) D_BLOCK(1, n2 + 1) }
        D_BLOCK(0, 8)
        local_store(CAT + (size_t)(seq0 + pq) * D + 768 + 64 * h + 4 * hh, O0, O1, lsum);
    }
#undef D_BLOCK
    }
    }
#undef LB_BLOCK
#undef LB_NEXT
#undef LB_LAST
    __syncthreads();
}
#define DPP_F(v, ctrl, rmask) __builtin_bit_cast(float, __builtin_amdgcn_update_dpp(0, __builtin_bit_cast(int, (v)), (ctrl), (rmask), 0xf, false))
DI float row16_sum(float v) {
    v += DPP_F(v, 0xB1, 0xf); v += DPP_F(v, 0x4E, 0xf); v += DPP_F(v, 0x141, 0xf); v += DPP_F(v, 0x140, 0xf);
    return v;
}
DI float row16_max(float v) {
    v = fmaxf(v, DPP_F(v, 0xB1, 0xf)); v = fmaxf(v, DPP_F(v, 0x4E, 0xf)); v = fmaxf(v, DPP_F(v, 0x141, 0xf)); v = fmaxf(v, DPP_F(v, 0x140, 0xf));
    return v;
}
DI float wave_sum_dpp(float v) {
    v = row16_sum(v);
    v += DPP_F(v, 0x142, 0xa);
    v += DPP_F(v, 0x143, 0xc);
    return __builtin_bit_cast(float, __builtin_amdgcn_readlane(__builtin_bit_cast(int, v), 63));
}
DI float reduce16(float (&v)[16], int lane) {
    { const bool up = (lane & 32) != 0;
#pragma unroll
      for (int k = 0; k < 8; ++k) { const float keep = up ? v[k + 8] : v[k], send = up ? v[k] : v[k + 8]; v[k] = keep + __shfl_xor(send, 32); } }
    { const bool up = (lane & 16) != 0;
#pragma unroll
      for (int k = 0; k < 4; ++k) { const float keep = up ? v[k + 4] : v[k], send = up ? v[k] : v[k + 4]; v[k] = keep + __shfl_xor(send, 16); } }
    { const bool up = (lane & 8) != 0;
#pragma unroll
      for (int k = 0; k < 2; ++k) { const float keep = up ? v[k + 2] : v[k], send = up ? v[k] : v[k + 2]; v[k] = keep + __shfl_xor(send, 8); } }
    { const bool up = (lane & 4) != 0; const float keep = up ? v[1] : v[0], send = up ? v[0] : v[1]; v[0] = keep + __shfl_xor(send, 4); }
    float r = v[0]; r += __shfl_xor(r, 2); r += __shfl_xor(r, 1);
    return r;
}

DI void ln1_phase(CParams p, int l, LAS unsigned char* lds, int tid, int wg, int G) {
    const int lane = tid & 63, gw = wg * NWAVES + (tid >> 6), NGW = G * NWAVES;
    LAS float* wr = (LAS float*)lds;
    for (int i = tid; i < D * NE; i += 512) wr[(i & 15) * D + (i >> 4)] = p->in[22][(size_t)l * D * NE + i];
    __syncthreads();
    const float* MOD = (const float*)(p->ws + WS_MOD) + (size_t)l * NSEQ * 6144;
    const bf16_t* MB = (const bf16_t*)(p->ws + WS_MBUF); unsigned char* H8 = p->ws + WS_H8; float* AFFT = (float*)(p->ws + WS_AFFT);
    const int per = (((M + NGW - 1) / NGW) + 1) & ~1;
    const bool il = (NGW * per == M);
    const int t0 = il ? wg * NWAVES * per + 2 * (tid >> 6) : gw * per, tstep = il ? 2 * NWAVES : 2, t1 = il ? (wg + 1) * NWAVES * per : ((gw * per + per < M) ? gw * per + per : M);
    f32x4 lng[4], lnb[4];
#pragma unroll
    for (int j = 0; j < 4; ++j) { lng[j] = *(const f32x4*)(p->in[18] + l * D + 4 * lane + 256 * j); lnb[j] = *(const f32x4*)(p->in[19] + l * D + 4 * lane + 256 * j); }
    int curb = -1; f32x4 g1p[4], sc2p[4], sh2[4];
    const bf16_t* XB = (const bf16_t*)p->out; bf16_t* X1 = (bf16_t*)(p->ws + WS_HB);
    const float* xin_p = p->in[0]; const float* xin_s = p->in[1];
    f32x4 xn[2][4]; u32x2 mwn[2][4];
#define LN1_FETCH(T_) { \
        if (l == 0) { const float* xr_ = x_row_of(xin_p, xin_s, (T_)); \
            _Pragma("unroll") for (int r_ = 0; r_ < 2; ++r_) _Pragma("unroll") for (int j = 0; j < 4; ++j) xn[r_][j] = __builtin_nontemporal_load((const f32x4*)(xr_ + (size_t)r_ * D + 4 * lane + 256 * j)); } \
        else { \
            _Pragma("unroll") for (int r_ = 0; r_ < 2; ++r_) _Pragma("unroll") for (int j = 0; j < 4; ++j) { const u32x2 w_ = __builtin_nontemporal_load((const u32x2*)(XB + (size_t)((T_) + r_) * D + 4 * lane + 256 * j)); \
                xn[r_][j][0] = __uint_as_float(w_.x); xn[r_][j][1] = __uint_as_float(w_.y); } } \
        _Pragma("unroll") for (int r_ = 0; r_ < 2; ++r_) _Pragma("unroll") for (int j = 0; j < 4; ++j) mwn[r_][j] = __builtin_nontemporal_load((const u32x2*)(MB + (size_t)((T_) + r_) * D + 4 * lane + 256 * j)); }
#pragma unroll
    for (int r = 0; r < 2; ++r)
#pragma unroll
        for (int j = 0; j < 4; ++j) xn[r][j] = (f32x4){0.f, 0.f, 0.f, 0.f};
    if (t0 < t1) LN1_FETCH(t0)
    for (int t = t0; t < t1; t += tstep) {
        const int b = t >> 12;
        if (b != curb) { curb = b; const float* mb = MOD + (size_t)b * 6144;
#pragma unroll
            for (int j = 0; j < 4; ++j) { g1p[j] = *(const f32x4*)(mb + 2048 + 4 * lane + 256 * j) + 1.f; sh2[j] = *(const f32x4*)(mb + 3072 + 4 * lane + 256 * j); sc2p[j] = *(const f32x4*)(mb + 4096 + 4 * lane + 256 * j) + 1.f; } }
        f32x4 v[2][4]; float s[2] = {0.f, 0.f};
#pragma unroll
        for (int r = 0; r < 2; ++r)
#pragma unroll
            for (int j = 0; j < 4; ++j) { const unsigned xa = __float_as_uint(xn[r][j][0]), xb = __float_as_uint(xn[r][j][1]);
                const f32x4 x = (l == 0) ? xn[r][j] : (f32x4){bf_lo(xa), bf_hi(xa), bf_lo(xb), bf_hi(xb)}; const u32x2 mw = mwn[r][j];
                const f32x4 mm = {bf_lo(mw.x), bf_hi(mw.x), bf_lo(mw.y), bf_hi(mw.y)};
                v[r][j] = x * ALPHA + g1p[j] * mm; s[r] += (v[r][j][0] + v[r][j][1]) + (v[r][j][2] + v[r][j][3]); }
        if (t + tstep < t1) LN1_FETCH(t + tstep)
        float s2[2] = {0.f, 0.f};
#pragma unroll
        for (int r = 0; r < 2; ++r) { const float mean = wave_sum_dpp(s[r]) * (1.f / D);
#pragma unroll
            for (int j = 0; j < 4; ++j) { v[r][j] = v[r][j] - mean; s2[r] += (v[r][j][0] * v[r][j][0] + v[r][j][1] * v[r][j][1]) + (v[r][j][2] * v[r][j][2] + v[r][j][3] * v[r][j][3]); } }
        f32x4 hh[2][4];
#pragma unroll
        for (int r = 0; r < 2; ++r) { const float rstd = __builtin_amdgcn_rsqf(wave_sum_dpp(s2[r]) * (1.f / D) + LN_EPS);
#pragma unroll
            for (int j = 0; j < 4; ++j) { const f32x4 y = v[r][j] * rstd * lng[j] + lnb[j];
                { u32x2 w; w.x = pk2(y[0], y[1]); w.y = pk2(y[2], y[3]); __builtin_nontemporal_store(w, (u32x2*)(X1 + (size_t)(t + r) * D + 4 * lane + 256 * j)); }
                hh[r][j] = y * sc2p[j] + sh2[j]; *(unsigned*)(H8 + (size_t)(t + r) * D + 4 * lane + 256 * j) = pg8::pk4_fp8(hh[r][j][0], hh[r][j][1], hh[r][j][2], hh[r][j][3]); } }
        float lg0[16], lg1[16];
        asm volatile("" ::: "memory");
        f32x2 hp[4][4];
#pragma unroll
        for (int j = 0; j < 4; ++j)
#pragma unroll
            for (int c = 0; c < 4; ++c) hp[j][c] = (f32x2){hh[0][j][c], hh[1][j][c]};
#pragma unroll
        for (int e = 0; e < 16; ++e) { f32x2 a = {0.f, 0.f};
#pragma unroll
            for (int j = 0; j < 4; ++j) { const f32x4 w = *(const LAS f32x4*)(wr + e * D + 4 * lane + 256 * j);
#pragma unroll
                for (int c = 0; c < 4; ++c) a = __builtin_elementwise_fma(hp[j][c], (f32x2){w[c], w[c]}, a); }
            lg0[e] = a.x; lg1[e] = a.y; }
        float logit0 = 0.f, logit1 = 0.f;
#pragma unroll
        for (int e = 0; e < 16; ++e) { const float a0 = wave_sum_dpp(lg0[e]), a1 = wave_sum_dpp(lg1[e]);
            logit0 = (lane & 15) == e ? a0 : logit0; logit1 = (lane & 15) == e ? a1 : logit1; }
        const float mx0 = row16_max(logit0), mx1 = row16_max(logit1);
        const float ex0 = __expf(logit0 - mx0), ex1 = __expf(logit1 - mx1);
        const float sm0 = row16_sum(ex0), sm1 = row16_sum(ex1);
#ifdef PROBE_NOAFFT
        if (p->ph_lo != 6)
#endif
        if (lane < 16) *(f32x2*)(AFFT + (size_t)lane * M + t) = (f32x2){ex0 / sm0, ex1 / sm1};
    }
#undef LN1_FETCH
}

constexpr int NPK = 2;
DI void ln2_pick(unsigned long long& m, int slot, int b0, int eb, int (&rw)[NPK], float (&kw)[NPK]) {
#pragma unroll
    for (int i = 0; i < NPK; ++i) { const bool h = m != 0ull; const int e = h ? __builtin_ctzll(m) : 0; m &= m - 1ull + (h ? 0ull : 1ull);
        const int sl = __builtin_amdgcn_readlane(slot, e); rw[i] = h ? b0 + e * eb + sl : 0; kw[i] = h ? 1.f : 0.f; }
}
DI void ln2_phase(CParams p, int l, int tid, int wg, int G) {
    const int lane = tid & 63, gw = wg * NWAVES + (tid >> 6), NGW = G * NWAVES;
    const float* MOD = (const float*)(p->ws + WS_MOD) + (size_t)l * NSEQ * 6144;
    const float* MODN = (const float*)(p->ws + WS_MOD) + (size_t)(l + 1) * NSEQ * 6144;
    const bf16_t* Y = (const bf16_t*)(p->ws + WS_Y); bf16_t* HB = (bf16_t*)(p->ws + WS_HB); const int* SEL = (const int*)(p->ws + WS_SEL);
    const int per = (((M + NGW - 1) / NGW) + 1) & ~1;
    const bool il = (NGW * per == M);
    const int t0 = il ? wg * NWAVES * per + 2 * (tid >> 6) : gw * per, tstep = il ? 2 * NWAVES : 2, t1 = il ? (wg + 1) * NWAVES * per : ((gw * per + per < M) ? gw * per + per : M);
    const bool has_next = (l + 1 < NL);
    f32x4 lng[4], lnb[4];
#pragma unroll
    for (int j = 0; j < 4; ++j) { lng[j] = *(const f32x4*)(p->in[20] + l * D + 4 * lane + 256 * j); lnb[j] = *(const f32x4*)(p->in[21] + l * D + 4 * lane + 256 * j); }
    int curb = -1; f32x4 g2p[4], sc1n[4], sh1n[4];
    bf16_t* XB = (bf16_t*)p->out;
    u32x2 xn[2][4]; int sn0 = -1, sn1 = -1;
#define LN2_FETCH(T_) { sn0 = -1; sn1 = -1; if (lane < 16) { const i32x2 q_ = *(const i32x2*)(SEL + (size_t)lane * M + (T_)); sn0 = q_.x; sn1 = q_.y; } \
        _Pragma("unroll") for (int r_ = 0; r_ < 2; ++r_) _Pragma("unroll") for (int j = 0; j < 4; ++j) xn[r_][j] = __builtin_nontemporal_load((const u32x2*)(HB + (size_t)((T_) + r_) * D + 4 * lane + 256 * j)); }
    if (t0 < t1) LN2_FETCH(t0)
    for (int t = t0; t < t1; t += tstep) {
        const int b = t >> 12;
        if (b != curb) { curb = b; const float* mb = MOD + (size_t)b * 6144; const float* mn = MODN + (size_t)b * 6144;
#pragma unroll
            for (int j = 0; j < 4; ++j) { g2p[j] = *(const f32x4*)(mb + 5120 + 4 * lane + 256 * j) + 1.f;
                if (has_next) { sh1n[j] = *(const f32x4*)(mn + 4 * lane + 256 * j); sc1n[j] = *(const f32x4*)(mn + 1024 + 4 * lane + 256 * j) + 1.f; } } }
        const int slot0 = sn0, slot1 = sn1; u32x2 xc[2][4];
#pragma unroll
        for (int r = 0; r < 2; ++r)
#pragma unroll
            for (int j = 0; j < 4; ++j) xc[r][j] = xn[r][j];
        unsigned long long m0 = __ballot(slot0 >= 0), m1 = __ballot(slot1 >= 0);
        f32x4 f[2][4];
#pragma unroll
        for (int r = 0; r < 2; ++r)
#pragma unroll
            for (int j = 0; j < 4; ++j) f[r][j] = (f32x4){0.f, 0.f, 0.f, 0.f};
        if (t + tstep < t1) LN2_FETCH(t + tstep)
        const int eb = t < MP ? 2048 : 8192, b0 = t < MP ? 0 : 32768;
        while (m0 | m1) {
            int rw0[NPK], rw1[NPK]; float kw0[NPK], kw1[NPK];
            ln2_pick(m0, slot0, b0, eb, rw0, kw0); ln2_pick(m1, slot1, b0, eb, rw1, kw1);
            u32x2 w0[NPK][4], w1[NPK][4];
#pragma unroll
            for (int i = 0; i < NPK; ++i)
#pragma unroll
                for (int j = 0; j < 4; ++j) { w0[i][j] = __builtin_nontemporal_load((const u32x2*)(Y + (size_t)rw0[i] * D + 4 * lane + 256 * j)); w1[i][j] = __builtin_nontemporal_load((const u32x2*)(Y + (size_t)rw1[i] * D + 4 * lane + 256 * j)); }
#pragma unroll
            for (int i = 0; i < NPK; ++i)
#pragma unroll
                for (int j = 0; j < 4; ++j) { f[0][j] += (f32x4){bf_lo(w0[i][j].x), bf_hi(w0[i][j].x), bf_lo(w0[i][j].y), bf_hi(w0[i][j].y)} * kw0[i];
                    f[1][j] += (f32x4){bf_lo(w1[i][j].x), bf_hi(w1[i][j].x), bf_lo(w1[i][j].y), bf_hi(w1[i][j].y)} * kw1[i]; }
        }
        f32x4 v[2][4]; float s[2] = {0.f, 0.f}, s2[2] = {0.f, 0.f};
#pragma unroll
        for (int r = 0; r < 2; ++r)
#pragma unroll
            for (int j = 0; j < 4; ++j) { const f32x4 x = {bf_lo(xc[r][j].x), bf_hi(xc[r][j].x), bf_lo(xc[r][j].y), bf_hi(xc[r][j].y)}; v[r][j] = x * ALPHA + g2p[j] * f[r][j]; s[r] += (v[r][j][0] + v[r][j][1]) + (v[r][j][2] + v[r][j][3]); }
#pragma unroll
        for (int r = 0; r < 2; ++r) { const float mean = wave_sum_dpp(s[r]) * (1.f / D);
#pragma unroll
            for (int j = 0; j < 4; ++j) { v[r][j] = v[r][j] - mean; s2[r] += (v[r][j][0] * v[r][j][0] + v[r][j][1] * v[r][j][1]) + (v[r][j][2] * v[r][j][2] + v[r][j][3] * v[r][j][3]); } }
#pragma unroll
        for (int r = 0; r < 2; ++r) { const float rstd = __builtin_amdgcn_rsqf(wave_sum_dpp(s2[r]) * (1.f / D) + LN_EPS);
#pragma unroll
            for (int j = 0; j < 4; ++j) { const f32x4 y = v[r][j] * rstd * lng[j] + lnb[j];
                if (has_next) { u32x2 w; w.x = pk2(y[0], y[1]); w.y = pk2(y[2], y[3]); __builtin_nontemporal_store(w, (u32x2*)(XB + (size_t)(t + r) * D + 4 * lane + 256 * j));
                    const f32x4 h = y * sc1n[j] + sh1n[j]; w.x = pk2(h[0], h[1]); w.y = pk2(h[2], h[3]); *(u32x2*)(HB + (size_t)(t + r) * D + 4 * lane + 256 * j) = w; }
                else __builtin_nontemporal_store(y, (f32x4*)(p->out + (size_t)(t + r) * D + 4 * lane + 256 * j)); } }
    }
#undef LN2_FETCH
}

DI unsigned block_sum(unsigned v, LAS unsigned* buf  , int lane, int wave) {
#pragma unroll
    for (int o = 1; o < 64; o <<= 1) v += __shfl_xor(v, o);
    if (lane == 0) buf[wave] = v;
    __syncthreads();
    unsigned t = 0;
#pragma unroll
    for (int w = 0; w < 8; ++w) t += buf[w];
    return t;
}
DI unsigned ult31(unsigned a, unsigned b) { return (a - b) >> 31; }
template <int VPT>
DI void topk_task(const float* v, int n_base_tok, int e, int cap, int rowbase, unsigned char* ws, LAS unsigned* sm, int tid) {
    const int lane = tid & 63, wave = tid >> 6;
    unsigned key[VPT];
#pragma unroll
    for (int k4 = 0; k4 < VPT / 4; ++k4) { const u32x4 w = *(const u32x4*)(v + (size_t)tid * VPT + 4 * k4); key[4 * k4] = w.x; key[4 * k4 + 1] = w.y; key[4 * k4 + 2] = w.z; key[4 * k4 + 3] = w.w; }
    unsigned thr = 0u;
    for (int bit = 30; bit >= 0; --bit) {
        const unsigned cand = thr | (1u << bit); unsigned c = 0;
#pragma unroll
        for (int k = 0; k < VPT; ++k) c += ult31(key[k], cand);
        const unsigned tot = 512u * VPT - block_sum(c, sm + (bit & 1) * 8, lane, wave);
        if (tot >= (unsigned)cap) thr = cand;
    }
    unsigned clt = 0, cle = 0;
#pragma unroll
    for (int k = 0; k < VPT; ++k) { clt += ult31(key[k], thr); cle += ult31(key[k], thr + 1u); }
    const unsigned cg = VPT - cle, ce = cle - clt;
    unsigned ig = cg, ie = ce;
#pragma unroll
    for (int o = 1; o < 64; o <<= 1) { const unsigned a = __shfl_up(ig, o), b = __shfl_up(ie, o); if (lane >= o) { ig += a; ie += b; } }
    __syncthreads();
    if (lane == 63) { sm[16 + wave] = ig; sm[24 + wave] = ie; }
    __syncthreads();
    unsigned og = 0, oe = 0, tg = 0;
#pragma unroll
    for (int w = 0; w < 8; ++w) { const unsigned a = sm[16 + w], b = sm[24 + w]; if (w < wave) { og += a; oe += b; } tg += a; }
    unsigned ng = og + ig - cg, ne = oe + ie - ce;
    const unsigned need_eq = (unsigned)cap - tg;
    int tok0 = n_base_tok + tid * VPT; asm volatile("" : "+v"(tok0));
    const unsigned trash = (unsigned)(WS_CTL + 32768) + 4u * (unsigned)tid;
#pragma unroll
    for (int k4 = 0; k4 < VPT / 4; ++k4) {
        unsigned so[4];
#pragma unroll
        for (int j = 0; j < 4; ++j) { const unsigned kk = key[4 * k4 + j]; const unsigned ge = 1u - ult31(kk, thr), gt = 1u - ult31(kk, thr + 1u), eq = ge - gt;
            const unsigned room = ult31(ne, need_eq);
            const unsigned selu = gt + eq * room;
            const unsigned slot = ng + (room ? ne : need_eq);
            const unsigned row = (unsigned)rowbase + slot;
            const unsigned oi = selu ? (unsigned)WS_IDX + 4u * row : trash, og2 = selu ? (unsigned)WS_GATE + 4u * row : trash + 2048u;
            *(int*)(ws + oi) = tok0 + 4 * k4 + j; *(unsigned*)(ws + og2) = kk;
            so[j] = (slot + 1u) * selu - 1u; ng += gt; ne += eq; }
        *(u32x4*)(ws + WS_SEL + ((size_t)e * M + tok0 + 4 * k4) * 4) = (u32x4){so[0], so[1], so[2], so[3]};
        __builtin_amdgcn_sched_barrier(0);
    }
    __syncthreads();
}
DI void topk_phase(CParams p, int l, LAS unsigned char* lds, int tid, int wg, int G) {
    LAS unsigned* sm = (LAS unsigned*)lds;
    const float* AFFT = (const float*)(p->ws + WS_AFFT);
    if (wg >= 2 * NE && G > 2 * NE) { const int wave = __builtin_amdgcn_readfirstlane(tid >> 6);
        convert_experts_wave(p, l, lds + wave * 4352, 0, CONV_EARLY, (wg - 2 * NE) * NWAVES + wave, (G - 2 * NE) * NWAVES, tid & 63); }
    for (int task = wg; task < 2 * NE; task += G) {
        const int g = task >> 4, e = task & 15;
        if (g == 0) topk_task<MP / 512>(AFFT + (size_t)e * M, 0, e, MP / 8, e * 2048, p->ws, sm, tid);
        else topk_task<(M - MP) / 512>(AFFT + (size_t)e * M + MP, MP, e, (M - MP) / 8, 32768 + e * 8192, p->ws, sm, tid);
    }
}
#ifndef VERIFY_MIXER
#define VERIFY_MIXER 0
#endif
#if VERIFY_MIXER
DI float bfv(const bf16_t* p) { return __uint_as_float((unsigned)(*p) << 16); }
DI void verify_phase(CParams p, int l, int tid, int wg, int G) {
#if VERIFY_MIXER <= 4
    const int lane = tid & 63, gw = wg * NWAVES + (tid >> 6), NGW = G * NWAVES;
    const bf16_t* U = (const bf16_t*)(p->ws + WS_U); const size_t US = (size_t)M * 256;
    const bf16_t* CAT = (const bf16_t*)(p->ws + WS_CAT);
    float* stat = (float*)(p->ws + WS_CTL + 40960);
    const float LN2 = 0.69314718056f;
    float sd = 0.f, sr = 0.f;
    constexpr int STRIDE = (VERIFY_MIXER <= 2) ? 61 : 13;
    for (int task = gw; task < (M / STRIDE) * 4; task += NGW) {
        const int tok = (task >> 2) * STRIDE, h = task & 3, seq0 = tok & ~(T - 1), t = tok & (T - 1);
        float ref = 0.f;
#if VERIFY_MIXER == 3
        const bf16_t* Q = U + 3 * US; const bf16_t* K = U + 4 * US; const bf16_t* V = U + 5 * US;
        const float q = bfv(Q + (size_t)tok * 256 + 64 * h + lane);
        float ob[3], lse[3];
        for (int br = 0; br < 3; ++br) { const int dil = br == 0 ? 1 : (br == 1 ? 4 : 16);
            float mx = -1e30f;
            for (int jj = -64; jj <= 64; ++jj) { const int tk = t + dil * jj; if (tk < 0 || tk >= T) continue; const float s = wave_sum(q * bfv(K + (size_t)(seq0 + tk) * 256 + 64 * h + lane)); mx = fmaxf(mx, s); }
            float den = 0.f, num = 0.f;
            for (int jj = -64; jj <= 64; ++jj) { const int tk = t + dil * jj; if (tk < 0 || tk >= T) continue; const float s = wave_sum(q * bfv(K + (size_t)(seq0 + tk) * 256 + 64 * h + lane)); const float e = exp2f(s - mx); den += e; num += e * bfv(V + (size_t)(seq0 + tk) * 256 + 64 * h + lane); }
            ob[br] = num / den; lse[br] = (mx + log2f(den)) * LN2; }
        const float lm = fmaxf(lse[0], fmaxf(lse[1], lse[2])); const float w0 = expf(lse[0] - lm), w1 = expf(lse[1] - lm), w2 = expf(lse[2] - lm);
        ref = (w0 * ob[0] + w1 * ob[1] + w2 * ob[2]) / (w0 + w1 + w2);
        const float got = bfv(CAT + (size_t)tok * D + 512 + 64 * h + lane);
#elif VERIFY_MIXER == 4
        const bf16_t* Q = U + 6 * US; const bf16_t* K = U + 7 * US; const bf16_t* V = U + 8 * US;
        const float q = bfv(Q + (size_t)tok * 256 + 64 * h + lane);
        const int row = t >> 6, col = t & 63; const int rs = min(max(row - 4, 0), 56), cs = min(max(col - 8, 0), 48);
        const float* rpb = p->in[14] + (size_t)l * 4 * 15 * 31 + (size_t)h * 15 * 31;
        float mx = -1e30f;
        for (int kr = 0; kr < 8; ++kr) for (int kc = 0; kc < 16; ++kc) { const int tk = (rs + kr) * 64 + cs + kc; const int ri = rs + kr - row + 7; int ci = cs + kc - col + 15; ci = min(max(ci, 0), 30);
            const float s = wave_sum(q * bfv(K + (size_t)(seq0 + tk) * 256 + 64 * h + lane)) + rpb[ri * 31 + ci] * LOG2E; mx = fmaxf(mx, s); }
        float den = 0.f, num = 0.f;
        for (int kr = 0; kr < 8; ++kr) for (int kc = 0; kc < 16; ++kc) { const int tk = (rs + kr) * 64 + cs + kc; const int ri = rs + kr - row + 7; int ci = cs + kc - col + 15; ci = min(max(ci, 0), 30);
            const float s = wave_sum(q * bfv(K + (size_t)(seq0 + tk) * 256 + 64 * h + lane)) + rpb[ri * 31 + ci] * LOG2E; const float e = exp2f(s - mx); den += e; num += e * bfv(V + (size_t)(seq0 + tk) * 256 + 64 * h + lane); }
        ref = num / den;
        const float got = bfv(CAT + (size_t)tok * D + 768 + 64 * h + lane);
#elif VERIFY_MIXER == 1
        const bf16_t* Q = U + 0 * US; const bf16_t* K = U + 1 * US; const bf16_t* V = U + 2 * US;
        const float q = bfv(Q + (size_t)tok * 256 + 64 * h + lane);
        float la = 0.f, lb = 0.f;
        { float a = 0.f, b = 0.f; if (lane < 32) { a = p->in[9][l * 32 + lane] * p->in[10][l * 32 + lane]; b = p->in[11][l * 32 + lane] * p->in[12][l * 32 + lane]; } a = wave_sum(a); b = wave_sum(b); la = expf(a) - expf(b) + p->lam_init[l]; }
        float m1 = -1e30f, m2 = -1e30f;
        for (int tk = 0; tk < T; ++tk) { const float pr = q * bfv(K + (size_t)(seq0 + tk) * 256 + 64 * h + lane); const float s1 = wave_sum(lane < 32 ? pr : 0.f), s2 = wave_sum(lane < 32 ? 0.f : pr); m1 = fmaxf(m1, s1); m2 = fmaxf(m2, s2); }
        float d1 = 0.f, d2 = 0.f, n1 = 0.f, n2 = 0.f;
        for (int tk = 0; tk < T; ++tk) { const float pr = q * bfv(K + (size_t)(seq0 + tk) * 256 + 64 * h + lane); const float s1 = wave_sum(lane < 32 ? pr : 0.f), s2 = wave_sum(lane < 32 ? 0.f : pr);
            const float e1 = exp2f(s1 - m1), e2 = exp2f(s2 - m2), v = bfv(V + (size_t)(seq0 + tk) * 256 + 64 * h + lane); d1 += e1; d2 += e2; n1 += e1 * v; n2 += e2 * v; }
        const float o = n1 / d1 - la * (n2 / d2);
        const float ms = wave_sum(o * o) * (1.f / 64.f);
        ref = o * rsqrtf(ms + RMS_EPS) * p->in[13][l * 64 + lane] * (1.f - p->lam_init[l]);
        (void)lb;
        const float got = bfv(CAT + (size_t)tok * D + 64 * h + lane);
#else
        const bf16_t* Q = (const bf16_t*)(p->ws + WS_QB); const bf16_t* K = (const bf16_t*)(p->ws + WS_KB); const bf16_t* V = (const bf16_t*)(p->ws + WS_VB);
        const float q0 = bfv(Q + (size_t)tok * 384 + 96 * h + lane), q1 = lane < 32 ? bfv(Q + (size_t)tok * 384 + 96 * h + 64 + lane) : 0.f;
        float mx = -1e30f;
        for (int tk = 0; tk < T; ++tk) { const bf16_t* kp = K + (size_t)(seq0 + tk) * 384 + 96 * h; const float s = wave_sum(q0 * bfv(kp + lane) + (lane < 32 ? q1 * bfv(kp + 64 + lane) : 0.f)); mx = fmaxf(mx, s); }
        float den = 0.f, num = 0.f;
        for (int tk = 0; tk < T; ++tk) { const bf16_t* kp = K + (size_t)(seq0 + tk) * 384 + 96 * h; const float s = wave_sum(q0 * bfv(kp + lane) + (lane < 32 ? q1 * bfv(kp + 64 + lane) : 0.f));
            const float e = exp2f(s - mx); den += e; num += e * bfv(V + (size_t)(seq0 + tk) * 256 + 64 * h + lane); }
        ref = num / den;
        const float got = bfv(CAT + (size_t)tok * D + 256 + 64 * h + lane);
#endif
        sd += (got - ref) * (got - ref); sr += ref * ref;
    }
    sd = wave_sum(sd); sr = wave_sum(sr);
    if (lane == 0) { atomicAdd(stat, sd); atomicAdd(stat + 1, sr); }
#endif
}

#if VERIFY_MIXER == 5 || VERIFY_MIXER == 6
DI void verify_producers(CParams p, int l, int tid, int wg, int G) {
    const int lane = tid & 63, gw = wg * NWAVES + (tid >> 6), NGW = G * NWAVES;
    const bf16_t* U = (const bf16_t*)(p->ws + WS_U); const size_t US = (size_t)M * 256;
    const bf16_t* UB = (const bf16_t*)(p->ws + WS_UB); const bf16_t* HB = (const bf16_t*)(p->ws + WS_HB);
    float* stat = (float*)(p->ws + WS_CTL + 40960);
    float sd = 0.f, sr = 0.f;
#if VERIFY_MIXER == 5
    const int secs[13] = {0, 256, 512, 768, 960, 1088, 1120, 1376, 1632, 1888, 2144, 2400, 2656};
    for (int task = gw; task < (M / 97) * 42; task += NGW) {
        const int tok = (task / 42) * 97; int blk = task % 42, sec = 0;
        for (;;) { const int nb = (secs[sec + 1] - secs[sec] + 63) / 64; if (blk < nb) break; blk -= nb; ++sec; }
        const int c = 64 * blk + lane, size = secs[sec + 1] - secs[sec]; const bool act = c < size; const int cs = secs[sec] + (act ? c : 0);
        float acc = 0.f;
        for (int k = 0; k < D; ++k) acc += bfv(HB + (size_t)tok * D + k) * p->in[4][((size_t)l * D + k) * 2656 + cs];
        const int pos = tok & (T - 1);
        float ref = acc; const bf16_t* got_p = nullptr;
        const bool ropeA = (sec == 0 || sec == 1), ropeC = (sec == 6 || sec == 7);
        if (ropeA) { const int dd = c & 31; const float up = __shfl(acc, (lane + 4) & 63), dn = __shfl(acc, (lane + 60) & 63);
            if (dd < 8) { const int j = dd & 3; const float ang = (float)pos * powf(500000.f, -(float)j / 4.f), cs_ = cosf(ang), sn = sinf(ang); ref = dd < 4 ? acc * cs_ - up * sn : acc * cs_ + dn * sn; } }
        if (ropeC) { const int dd = c & 63; const float up = __shfl(acc, (lane + 8) & 63), dn = __shfl(acc, (lane + 56) & 63);
            if (dd < 16) { const int j = dd & 7; const float ang = (float)pos * powf(500000.f, -(float)j / 8.f), cs_ = cosf(ang), sn = sinf(ang); ref = dd < 8 ? acc * cs_ - up * sn : acc * cs_ + dn * sn; } }
        if (sec == 0) ref *= 0.17677669529663689f * LOG2E; if (sec == 6 || sec == 9) ref *= 0.125f * LOG2E;
        if (sec <= 2) got_p = U + (size_t)sec * US + (size_t)tok * 256 + c;
        else if (sec == 3) got_p = UB + (size_t)tok * 512 + c; else if (sec == 4) got_p = UB + (size_t)tok * 512 + 256 + c; else if (sec == 5) got_p = UB + (size_t)tok * 512 + 384 + c;
        else got_p = U + (size_t)(sec - 3) * US + (size_t)tok * 256 + c;
        if (act) { const float got = bfv(got_p); sd += (got - ref) * (got - ref); sr += ref * ref; }
    }
#else
    const bf16_t* QB = (const bf16_t*)(p->ws + WS_QB); const bf16_t* KB = (const bf16_t*)(p->ws + WS_KB); const bf16_t* VB = (const bf16_t*)(p->ws + WS_VB);
    for (int task = gw; task < (M / 97) * 15; task += NGW) {
        const int tok = (task / 15) * 97, blk = task % 15, pos = tok & (T - 1);
        float ref = 0.f, got = 0.f; bool act = true;
        if (blk < 6) { const int n = 64 * blk + lane; float ms = 0.f; for (int k = 0; k < 192; ++k) { const float x = bfv(UB + (size_t)tok * 512 + k); ms += x * x; }
            const float rs = rsqrtf(ms / 192.f + RMS_EPS); float acc = 0.f;
            for (int k = 0; k < 192; ++k) acc += bfv(UB + (size_t)tok * 512 + k) * rs * p->in[7][l * 192 + k] * p->in[5][((size_t)l * 192 + k) * 384 + n];
            const int w = n % 96; const float up = __shfl(acc, (lane + 16) & 63), dn = __shfl(acc, (lane + 48) & 63); ref = acc;
            if (w >= 64) { const int rd = w - 64, j = rd & 15; const float ang = (float)pos * powf(10000.f, -(float)j / 16.f), cs_ = cosf(ang), sn = sinf(ang); ref = rd < 16 ? acc * cs_ - up * sn : acc * cs_ + dn * sn; }
            ref *= 0.10206207261596575f * LOG2E; got = bfv(QB + (size_t)tok * 384 + n);
        } else if (blk < 14) { const int n = 64 * (blk - 6) + lane; float ms = 0.f; for (int k = 0; k < 128; ++k) { const float x = bfv(UB + (size_t)tok * 512 + 256 + k); ms += x * x; }
            const float rs = rsqrtf(ms / 128.f + RMS_EPS); float acc = 0.f;
            for (int k = 0; k < 128; ++k) acc += bfv(UB + (size_t)tok * 512 + 256 + k) * rs * p->in[8][l * 128 + k] * p->in[6][((size_t)l * 128 + k) * 512 + n];
            ref = acc; const int h = n >> 7, w = n & 127; got = w < 64 ? bfv(KB + (size_t)tok * 384 + 96 * h + w) : bfv(VB + (size_t)tok * 256 + 64 * h + (w - 64));
        } else { act = lane < 32; const int d = lane & 31; const float x = bfv(UB + (size_t)tok * 512 + 384 + d); const float up = __shfl(x, (lane + 16) & 63), dn = __shfl(x, (lane + 48) & 63);
            const int j = d & 15; const float ang = (float)pos * powf(10000.f, -(float)j / 16.f), cs_ = cosf(ang), sn = sinf(ang); ref = d < 16 ? x * cs_ - up * sn : x * cs_ + dn * sn;
            float e2 = 0.f, r2 = 0.f; for (int h = 0; h < 4; ++h) { const float g = bfv(KB + (size_t)tok * 384 + 96 * h + 64 + d); e2 += (g - ref) * (g - ref); r2 += ref * ref; }
            if (act) { sd += e2; sr += r2; } act = false; }
        if (act) { sd += (got - ref) * (got - ref); sr += ref * ref; }
    }
#endif
    sd = wave_sum(sd); sr = wave_sum(sr);
    if (lane == 0) { atomicAdd(stat, sd); atomicAdd(stat + 1, sr); }
}
#endif
DI void verify_scale(CParams p, int tid, int wg, int G) {
    const float* stat = (const float*)(p->ws + WS_CTL + 40960);
    const float ratio = __hip_atomic_load(stat, RLX_AGENT) / fmaxf(__hip_atomic_load(stat + 1, RLX_AGENT), 1e-30f);
    const float f = 1.f + 10.f * sqrtf(ratio);
    for (size_t i = (size_t)wg * 512 + tid; i < (size_t)M * D / 4; i += (size_t)G * 512) { f32x4 v = ((f32x4*)p->out)[i]; ((f32x4*)p->out)[i] = v * f; }
}
#endif
#ifndef MK_SPLIT
#define MK_SPLIT 0
#endif
constexpr int STEPS_PER_LAYER = 7 + 2 * NCHUNK;
constexpr int NSTEPS = 2 + NL * STEPS_PER_LAYER;

__global__ void __launch_bounds__(NWAVES * 64, 2) mega_fwd(Params pk) {
    extern __shared__ __attribute__((aligned(16))) unsigned char lds_raw[];
    LAS unsigned char* lds = (LAS unsigned char*)lds_raw;
    const int tid0 = threadIdx.x;
    const int wave_s = __builtin_amdgcn_readfirstlane(tid0 >> 6);
    volatile LAS unsigned* MISC = (volatile LAS unsigned*)(lds + MISC_OFF);
    for (int u = tid0; u < (LDS_BYTES - RING_BYTES) / 4; u += NWAVES * 64) ((LAS unsigned*)(lds + RING_BYTES))[u] = 0u;
    __syncthreads();
    XcdBarrier bar; bar.bar = (unsigned*)(pk.ws + WS_CTL); bar.x = 0; bar.st = nullptr;
    if (!MK_SPLIT) bar = xcd_barrier_post((unsigned*)(pk.ws + WS_CTL), MISC + 8);
    const int lo = pk.ph_lo, hi = pk.ph_hi;
    int step = 0;
#ifndef PHMASK
#define PHMASK 0xffff
#endif
#define RUN() (lo <= step && step < hi)
#define PH(b) ((PHMASK >> (b)) & 1)
#ifndef DUPMASK
#define DUPMASK 0
#endif
#define REP(b) for (int rep_ = 0, nrep_ = ((DUPMASK >> (b)) & 1) ? opaque_int(2) : 1; rep_ < nrep_; ++rep_)
#define PH_LOCALS unsigned z_ = 0u; asm volatile("" : "+s"(z_)); int tid = (wave_s << 6) | (int)__builtin_amdgcn_mbcnt_hi(~0u, __builtin_amdgcn_mbcnt_lo(~0u, z_)), wg = blockIdx.x, G = gridDim.x; asm volatile("" : "+v"(tid), "+s"(wg), "+s"(G)); CParams p = launder_args()
#define SEAM() do { if (lo <= step && step + 1 < hi) xcd_barrier(bar); ++step; } while (0)

    if (PH(0) && RUN()) { PH_LOCALS; REP(0) prologue_a(p, lds, tid, wg, G); }
    SEAM();
    if (PH(1) && RUN()) { PH_LOCALS; REP(1) prologue_b(p, lds, tid, wg, G); }
    SEAM();
    for (int l = 0; l < NL; ++l) {
        if (PH(2) && RUN()) {
            PH_LOCALS;
            pg8::ProbPlain P{(const bf16_t*)(p->ws + WS_HB), (const bf16_t*)(p->ws + WS_WIN_T) + (size_t)l * N1 * D, D};
            pg8::StaticOrder S; S.init(M / 256, N1 / 256, G, wg);
            pg8::EpiInProj E{(bf16_t*)(p->ws + WS_U), (bf16_t*)(p->ws + WS_UB), (const f32x2*)(p->ws + WS_ROPEA), (const f32x2*)(p->ws + WS_ROPEC), 0.17677669529663689f * LOG2E, 0.125f * LOG2E};
#ifdef PROBE_EPI
            if (lo == 2 && hi == 3) { pg8::EpiStore E2{(bf16_t*)(p->ws + WS_U), 2816}; pg8::gemm_phase(lds, P, S, E2, tid); } else
#endif
            REP(2) pg8::gemm_phase(lds, P, S, E, tid);
        }
        SEAM();
        if (PH(3) && RUN()) { PH_LOCALS; REP(3) mla_phase(p, l, lds, tid, wg, G); }
        SEAM();
        if (PH(4) && RUN()) { PH_LOCALS; REP(4) attn_phase(p, l, lds, tid, wg, G); }
#if VERIFY_MIXER
        if (l == 0) { xcd_barrier(bar); PH_LOCALS; verify_phase(p, l, tid, wg, G); }
#endif
#if VERIFY_MIXER == 5 || VERIFY_MIXER == 6
        if (l == 0) { PH_LOCALS; verify_producers(p, l, tid, wg, G); }
#endif
        SEAM();
        if (PH(5) && RUN()) {
            PH_LOCALS;
            pg8::ProbPlain P{(const bf16_t*)(p->ws + WS_CAT), (const bf16_t*)(p->ws + WS_WOUT_T) + (size_t)l * D * D, D};
            pg8::StaticOrder S; S.init(M / 256, D / 256, G, wg);
            pg8::EpiStore E{(bf16_t*)(p->ws + WS_MBUF), D};
            REP(5) pg8::gemm_phase(lds, P, S, E, tid);
        }
        SEAM();
        if (PH(6) && RUN()) { PH_LOCALS; for (int rep_ = 0, nrep_ = (((DUPMASK >> 6) & 1) && l == 0) ? opaque_int(2) : 1; rep_ < nrep_; ++rep_) ln1_phase(p, l, lds, tid, wg, G); }
        SEAM();
        if (PH(7) && RUN()) { PH_LOCALS; REP(7) topk_phase(p, l, lds, tid, wg, G); }
        SEAM();
#ifndef MOE_REP
#define MOE_REP 1
#endif
        for (int c2 = 0; c2 < NCHUNK * MOE_REP; ++c2) { const int c = c2 % NCHUNK;
            if (PH(8) && RUN()) {
                PH_LOCALS;
                pg8::ProbMoeUp P{p->ws + WS_H8, p->ws + WS_WGU_T + (size_t)l * NE * 2 * FF * D, (const int*)(p->ws + WS_IDX), c, D};
                pg8::StaticOrder S; S.init(CHUNK_PANELS, 2 * FF / 256, G, wg);
                pg8::EpiSwiGLU E{p->ws + WS_ACT};
                REP(8) pg8::gemm_phase(lds, P, S, E, tid);
            }
            SEAM();
            if (PH(9) && RUN()) {
                PH_LOCALS;
                pg8::ProbMoeDown P{p->ws + WS_ACT, p->ws + WS_WD_T + (size_t)l * NE * D * FF, c, FF};
                pg8::StaticOrder S; S.init(CHUNK_PANELS, D / 256, G, wg);
                pg8::EpiDown E{(bf16_t*)(p->ws + WS_Y), (const float*)(p->ws + WS_GATE), c};
                REP(9) pg8::gemm_phase(lds, P, S, E, tid);
            }
            SEAM();
        }
        if (PH(10) && RUN()) {
            PH_LOCALS;
            ln2_phase(p, l, tid, wg, G);
        }
        SEAM();
    }
#if VERIFY_MIXER
    { xcd_barrier(bar); PH_LOCALS; verify_scale(p, tid, wg, G); }
#endif
#ifndef EXTRA_BARS
#define EXTRA_BARS 0
#endif
    for (int i = 0; i < EXTRA_BARS; ++i) xcd_barrier(bar);
#undef RUN
#undef SEAM
}

extern "C" void kernel_launch(void* const* d_in, const int* in_sizes, int n_in, void* d_out, int out_size, void* d_ws, size_t ws_size, hipStream_t stream) {
    static int grid = 0;
    if (grid == 0) {
        if (n_in != 26 || in_sizes[0] != MP * D || out_size != M * D || ws_size < WS_END) {
            fprintf(stderr, "kernel_launch: unexpected shapes (n_in %d, in0 %d, out %d, ws %zu, need %zu); nothing launched\n", n_in, n_in > 0 ? in_sizes[0] : -1, out_size, ws_size, (size_t)WS_END); grid = -1; return; }
        int dev = 0, cus = 0, per_cu = 0;
        if (hipGetDevice(&dev) != hipSuccess || hipDeviceGetAttribute(&cus, hipDeviceAttributeMultiprocessorCount, dev) != hipSuccess) { fprintf(stderr, "kernel_launch: device query failed\n"); grid = -1; return; }
        if (hipFuncSetAttribute((const void*)mega_fwd, hipFuncAttributeMaxDynamicSharedMemorySize, LDS_BYTES) != hipSuccess) { fprintf(stderr, "kernel_launch: hipFuncSetAttribute failed\n"); grid = -1; return; }
        if (hipOccupancyMaxActiveBlocksPerMultiprocessor(&per_cu, (const void*)mega_fwd, NWAVES * 64, LDS_BYTES) != hipSuccess || per_cu < 1)
            fprintf(stderr, "kernel_launch: note: occupancy query reports %d workgroups per CU\n", per_cu);
        (void)hipGetLastError();
        grid = cus;
    }
    if (grid < 0) return;
    if (hipMemsetAsync((char*)d_ws + WS_CTL, 0, CTL_BYTES, stream) != hipSuccess) { fprintf(stderr, "kernel_launch: memset failed\n"); return; }
    Params a{};
    for (int i = 0; i < 26; ++i) a.in[i] = (const float*)d_in[i];
    a.out = (float*)d_out; a.ws = (unsigned char*)d_ws;
    for (int j = 0; j < 4; ++j) a.invA[j] = pow(500000.0, -(double)j / 4.0);
    for (int j = 0; j < 8; ++j) a.invC[j] = pow(500000.0, -(double)j / 8.0);
    for (int j = 0; j < 16; ++j) a.invB[j] = pow(10000.0, -(double)j / 16.0);
    for (int l = 0; l < NL; ++l) a.lam_init[l] = (float)(0.8 - 0.6 * exp(-0.3 * (double)l));
#if MK_SPLIT
    for (int s = 0; s < NSTEPS; ++s) { a.ph_lo = s; a.ph_hi = s + 1; hipLaunchKernelGGL(mega_fwd, dim3(grid), dim3(NWAVES * 64), LDS_BYTES, stream, a); }
#else
    a.ph_lo = 0; a.ph_hi = NSTEPS * 4;
    hipLaunchKernelGGL(mega_fwd, dim3(grid), dim3(NWAVES * 64), LDS_BYTES, stream, a);
#ifdef PROBE_STEP
    a.ph_lo = PROBE_STEP; a.ph_hi = PROBE_STEP + 1;
    hipLaunchKernelGGL(mega_fwd, dim3(grid), dim3(NWAVES * 64), LDS_BYTES, stream, a);
#endif
#endif
    const hipError_t le = hipPeekAtLastError();
    if (le != hipSuccess) fprintf(stderr, "kernel_launch: launch failed: %s\n", hipGetErrorName(le));
}
```

```cpp
#include <hip/hip_runtime.h>
#include <cstdio>
#include <cstdint>
#include <cmath>

#define DI __device__ __forceinline__
#define LAS __attribute__((address_space(3)))
#define GAS __attribute__((address_space(1)))
#define RLX_AGENT __ATOMIC_RELAXED, __HIP_MEMORY_SCOPE_AGENT
#define LDS_WAIT() asm volatile("s_waitcnt lgkmcnt(0)" ::: "memory")
#define VM_WAIT() asm volatile("s_waitcnt vmcnt(0)" ::: "memory")

typedef unsigned short bf16_t;
typedef short bf16x8 __attribute__((ext_vector_type(8)));
typedef short s16x4 __attribute__((ext_vector_type(4)));
typedef float f32x4 __attribute__((ext_vector_type(4)));
typedef float f32x2 __attribute__((ext_vector_type(2)));
typedef int i32x2 __attribute__((ext_vector_type(2)));
typedef float f32x16 __attribute__((ext_vector_type(16)));
typedef unsigned u32x4 __attribute__((ext_vector_type(4)));
typedef unsigned u32x2 __attribute__((ext_vector_type(2)));
typedef __bf16 bf16v2 __attribute__((ext_vector_type(2)));
typedef int i32x8 __attribute__((ext_vector_type(8)));
typedef int i32x4 __attribute__((ext_vector_type(4)));

constexpr int D = 1024, T = 4096, NSEQ = 20, M = NSEQ * T  , MP = 4 * T  ;
constexpr int NL = 2, NE = 16, FF = 2816;
constexpr int N1 = 2816;
constexpr int NROWS = 2 * M;
constexpr int CHUNK_PANELS = 640, NCHUNK = 1;
constexpr float LN_EPS = 1e-5f, RMS_EPS = 1e-6f;
constexpr float ALPHA = 1.41421356237309515f;
constexpr float LOG2E = 1.44269504088896341f;
constexpr int NWAVES = 8;

DI unsigned pk2(float lo, float hi) { bf16v2 v = {(__bf16)lo, (__bf16)hi}; return __builtin_bit_cast(unsigned, v); }
DI float bf_lo(unsigned w) { return __uint_as_float(w << 16); }
DI float bf_hi(unsigned w) { return __uint_as_float(w & 0xffff0000u); }
DI int opaque_int(int v) { asm volatile("" : "+s"(v)); return v; }
DI float wave_sum(float v) {
#pragma unroll
    for (int o = 1; o < 64; o <<= 1) v += __shfl_xor(v, o);
    return v;
}

namespace pg8 {
constexpr int BM = 256, BK = 64, HALF = 128, HTB = HALF * BK * 2, STAGE_BYTES = 8 * HTB, NXCD = 8, WGM = 8;
__host__ __device__ __forceinline__ int lds_byte(int r, int c) { const int st = (r >> 4) * 2 + (c >> 5), rr = r & 15, cc = c & 31, ob = rr * 64 + cc * 2; return st * 1024 + (ob ^ (((ob >> 9) & 1) << 5)); }
__host__ __device__ __forceinline__ void stage_rc(int b, int& R, int& C) { const int st = b / 1024, sb = b % 1024, swz = sb ^ (((sb >> 9) & 1) << 5); R = (st >> 1) * 16 + swz / 64; C = (st & 1) * 32 + (swz % 64) / 2; }
__host__ __device__ __forceinline__ int perm32(int rho) { const int n = rho >> 4, i = rho & 15; return 8 * (i >> 2) + 4 * n + (i & 3); }

struct Unit { int pm, pn; };
struct StaticOrder {
    int nM, nN, nwg, G, c;
    __host__ __device__ void init(int nM_, int nN_, int G_, int c_) { nM = nM_; nN = nN_; nwg = nM * nN; G = G_; c = c_; }
    __host__ __device__ bool next(int i, Unit& u) const {
        const long L = (long)i * G + c; if (L >= nwg) return false;
        int wgid = (int)L; { const int q = nwg / NXCD, r = nwg % NXCD, xcd = wgid % NXCD, off = wgid / NXCD; wgid = (xcd < r ? xcd * (q + 1) : r * (q + 1) + (xcd - r) * q) + off; }
        const int nig = WGM * nN, gid = wgid / nig, fm = gid * WGM, gsz = (nM - fm) < WGM ? (nM - fm) : WGM;
        u.pm = fm + ((wgid % nig) % gsz); u.pn = (wgid % nig) / gsz; return true;
    }
};

template <class Epi, class Prob, class Sched>
DI void gemm_phase(LAS unsigned char* lds, const Prob& P, const Sched& S, const Epi& E, const int tid) {
    const int wid = __builtin_amdgcn_readfirstlane(tid >> 6), lane = tid & 63, wr = wid >> 2, wc = wid & 3, fr = lane & 15, fq = lane >> 4;
    constexpr bool F8 = Prob::FP8;
    const int K = P.K, rowb = F8 ? K : 2 * K, nt = rowb / (BK * 2);
    unsigned voffB[2]; int RA[2]; unsigned CA2[2];
#pragma unroll
    for (int i = 0; i < 2; ++i) { int R, C; stage_rc(tid * 16 + i * 8192, R, C); const int Rb = (R & ~31) + perm32(R & 31);
        voffB[i] = (unsigned)(Rb * rowb) + (unsigned)C * 2u; RA[i] = R; CA2[i] = (unsigned)C * 2u; }
    const size_t kstep = (size_t)(BK * 2);
    const size_t hstep = (size_t)HALF * rowb;
    const unsigned ldsw = (unsigned)wid * 1024u;
    const int aoff = lds_byte(wr * 64 + fr, fq * 8), boff = lds_byte(wc * 32 + fr, fq * 8);
    constexpr int off1 = 1024;
    const unsigned adrA = (unsigned)(size_t)lds + (unsigned)aoff, adrB = (unsigned)(size_t)lds + 4u * HTB + (unsigned)boff;
#define PG8_SA(b, h) (((b) * 2 + (h)) * HTB)
#define PG8_SB(b, h) ((4 + (b) * 2 + (h)) * HTB)
#define PG8_STAGE(bufoff, gbase, voff) do { _Pragma("unroll") for (int _i = 0; _i < 2; ++_i) \
        __builtin_amdgcn_global_load_lds((const unsigned*)((const char*)(gbase) + (voff)[_i]), (LAS unsigned*)(lds + (bufoff) + ldsw + _i * 8192), 16, 0, 0); } while (0)
#define PG8_DSR(dst, addr, off) asm volatile("ds_read_b128 %0, %1 offset:%2" : "=v"(dst) : "v"(addr), "n"(off) : "memory")
#define PG8_LDA(dst, b, h) do { \
        PG8_DSR(dst[0][0], adrA, ((b) * 2 + (h)) * HTB + 0 * 2048 + 0 * 1024); PG8_DSR(dst[0][1], adrA, ((b) * 2 + (h)) * HTB + 0 * 2048 + 1 * 1024); \
        PG8_DSR(dst[1][0], adrA, ((b) * 2 + (h)) * HTB + 1 * 2048 + 0 * 1024); PG8_DSR(dst[1][1], adrA, ((b) * 2 + (h)) * HTB + 1 * 2048 + 1 * 1024); \
        PG8_DSR(dst[2][0], adrA, ((b) * 2 + (h)) * HTB + 2 * 2048 + 0 * 1024); PG8_DSR(dst[2][1], adrA, ((b) * 2 + (h)) * HTB + 2 * 2048 + 1 * 1024); \
        PG8_DSR(dst[3][0], adrA, ((b) * 2 + (h)) * HTB + 3 * 2048 + 0 * 1024); PG8_DSR(dst[3][1], adrA, ((b) * 2 + (h)) * HTB + 3 * 2048 + 1 * 1024); } while (0)
#define PG8_LDB(dst, b, h) do { \
        PG8_DSR(dst[0][0], adrB, ((b) * 2 + (h)) * HTB + 0 * 2048 + 0 * 1024); PG8_DSR(dst[0][1], adrB, ((b) * 2 + (h)) * HTB + 0 * 2048 + 1 * 1024); \
        PG8_DSR(dst[1][0], adrB, ((b) * 2 + (h)) * HTB + 1 * 2048 + 0 * 1024); PG8_DSR(dst[1][1], adrB, ((b) * 2 + (h)) * HTB + 1 * 2048 + 1 * 1024); } while (0)
#define PG8_MFMA(ai, bj, m, n, At, Bt) do { \
        if constexpr (F8) { const i32x8 b8_ = __builtin_bit_cast(i32x8, __builtin_shufflevector(Bt[n][0], Bt[n][1], 0, 1, 2, 3, 4, 5, 6, 7, 8, 9, 10, 11, 12, 13, 14, 15)), a8_ = __builtin_bit_cast(i32x8, __builtin_shufflevector(At[m][0], At[m][1], 0, 1, 2, 3, 4, 5, 6, 7, 8, 9, 10, 11, 12, 13, 14, 15)); \
            asm volatile("v_mfma_scale_f32_16x16x128_f8f6f4 %0, %1, %2, %0, %3, %4 op_sel_hi:[0,0,0]" : "+v"(acc[ai][bj][m][n]) : "v"(b8_), "v"(a8_), "v"(sclB), "v"(sclA)); } \
        else { _Pragma("unroll") for (int k = 0; k < 2; ++k) acc[ai][bj][m][n] = __builtin_amdgcn_mfma_f32_16x16x32_bf16(Bt[n][k], At[m][k], acc[ai][bj][m][n], 0, 0, 0); } } while (0)
#define PG8_WL(N, At, m) asm volatile("s_waitcnt lgkmcnt(" #N ")" : "+v"(At[m][0]), "+v"(At[m][1]) :: "memory")
#define PG8_WLB(N, At, Ba, Bb) asm volatile("s_waitcnt lgkmcnt(" #N ")" : "+v"(At[0][0]), "+v"(At[0][1]), "+v"(Ba[0][0]), "+v"(Ba[0][1]), "+v"(Ba[1][0]), "+v"(Ba[1][1]), "+v"(Bb[0][0]), "+v"(Bb[0][1]), "+v"(Bb[1][0]), "+v"(Bb[1][1]) :: "memory")
#ifndef PG8_PRIO
#define PG8_PRIO 1
#endif
#define PG8_SETPRIO(x) do { if (PG8_PRIO) __builtin_amdgcn_s_setprio(x); } while (0)
#define PG8_MMA2(ai, At, Ba, Bb, FIRST) do { PG8_SETPRIO(1); \
        FIRST; PG8_MFMA(ai, 0, 0, 0, At, Ba); PG8_MFMA(ai, 0, 0, 1, At, Ba); \
        PG8_WL(4, At, 1); PG8_MFMA(ai, 0, 1, 0, At, Ba); PG8_MFMA(ai, 0, 1, 1, At, Ba); \
        PG8_WL(2, At, 2); PG8_MFMA(ai, 0, 2, 0, At, Ba); PG8_MFMA(ai, 0, 2, 1, At, Ba); \
        PG8_WL(0, At, 3); PG8_MFMA(ai, 0, 3, 0, At, Ba); PG8_MFMA(ai, 0, 3, 1, At, Ba); \
        PG8_SETPRIO(0); PG8_SETPRIO(1); \
        PG8_MFMA(ai, 1, 0, 0, At, Bb); PG8_MFMA(ai, 1, 0, 1, At, Bb); PG8_MFMA(ai, 1, 1, 0, At, Bb); PG8_MFMA(ai, 1, 1, 1, At, Bb); \
        PG8_MFMA(ai, 1, 2, 0, At, Bb); PG8_MFMA(ai, 1, 2, 1, At, Bb); PG8_MFMA(ai, 1, 3, 0, At, Bb); PG8_MFMA(ai, 1, 3, 1, At, Bb); \
        PG8_SETPRIO(0); } while (0)
#define PG8_WAIT_V(n) asm volatile("s_waitcnt vmcnt(" #n ")" ::: "memory")
#define PG8_WAIT_L(n) asm volatile("" ::: "memory")
#define PG8_BAR __builtin_amdgcn_s_barrier()
#define PG8_SCHED __builtin_amdgcn_sched_barrier(0)
    const int sclA = Prob::SCALE_A, sclB = Prob::SCALE_B;
    Unit cur, nxt; int ui = 0;
    if (!S.next(0, cur)) return;
    f32x4 acc[2][2][4][2];
#pragma unroll
    for (int a = 0; a < 2; ++a)
#pragma unroll
        for (int b = 0; b < 2; ++b)
#pragma unroll
            for (int m = 0; m < 4; ++m)
#pragma unroll
                for (int n = 0; n < 2; ++n) acc[a][b][m][n] = (f32x4){0.f, 0.f, 0.f, 0.f};
    bf16x8 At[4][2], B0[2][2], B1[2][2];
    unsigned aoC[2][2], aoN[2][2];
#pragma unroll
    for (int h = 0; h < 2; ++h)
#pragma unroll
        for (int i = 0; i < 2; ++i) { aoC[h][i] = P.a_off(cur, h * HALF + RA[i]) + CA2[i]; aoN[h][i] = aoC[h][i]; }
    const char* cA = P.a_base(cur); const char* cB = P.b_base(cur);
    PG8_STAGE(PG8_SB(0, 0), cB, voffB); PG8_STAGE(PG8_SB(0, 1), cB + hstep, voffB); PG8_STAGE(PG8_SA(0, 0), cA, aoC[0]); PG8_STAGE(PG8_SA(0, 1), cA, aoC[1]);
    if (wr == 1) PG8_BAR;
    PG8_WAIT_V(2); PG8_BAR;
    PG8_STAGE(PG8_SB(1, 0), cB + kstep, voffB); PG8_STAGE(PG8_SA(1, 0), cA + kstep, aoC[0]); PG8_STAGE(PG8_SB(1, 1), cB + hstep + kstep, voffB);
    PG8_WAIT_V(6); PG8_BAR;
    for (;;) {
        const bool has_next = S.next(ui + 1, nxt);
        const char* nA = has_next ? P.a_base(nxt) : cA; const char* nB = has_next ? P.b_base(nxt) : cB;
        int rawN[2][2]; const bool pendN = Prob::GATHER && has_next && nt >= 6;
        if constexpr (Prob::GATHER) {
#pragma unroll
            for (int h = 0; h < 2; ++h)
#pragma unroll
                for (int i = 0; i < 2; ++i) { const int* ip_ = P.idx_ptr(has_next ? nxt : cur, h * HALF + RA[i]); asm volatile("global_load_dword %0, %1, off" : "=v"(rawN[h][i]) : "v"(ip_) : "memory"); }
        }
        if (Prob::GATHER) {
            if (has_next && !pendN) {
#pragma unroll
                for (int h = 0; h < 2; ++h)
#pragma unroll
                    for (int i = 0; i < 2; ++i) aoN[h][i] = P.a_off(nxt, h * HALF + RA[i]) + CA2[i];
            } else if (!has_next) {
#pragma unroll
                for (int h = 0; h < 2; ++h)
#pragma unroll
                    for (int i = 0; i < 2; ++i) aoN[h][i] = aoC[h][i];
            }
        }
        for (int t = 0; t < nt; t += 2) {
            const bool last = (t == nt - 2);
            if constexpr (Prob::GATHER) {
                if (t == 2) asm volatile("" : "+v"(rawN[0][0]), "+v"(rawN[0][1]), "+v"(rawN[1][0]), "+v"(rawN[1][1]));
                if (pendN && t == 2) {
#pragma unroll
                    for (int h = 0; h < 2; ++h)
#pragma unroll
                        for (int i = 0; i < 2; ++i) aoN[h][i] = P.off_of_idx(rawN[h][i]) + CA2[i];
                }
            }
            const char* a1 = cA + (size_t)(t + 1) * kstep;
            const char* a2 = last ? nA : cA + (size_t)(t + 2) * kstep; const char* b2 = last ? nB : cB + (size_t)(t + 2) * kstep;
            const char* a3 = a2 + kstep; const char* b3 = b2 + kstep;
            unsigned ao2[2][2];
#pragma unroll
            for (int h = 0; h < 2; ++h)
#pragma unroll
                for (int i = 0; i < 2; ++i) ao2[h][i] = (Prob::GATHER && last) ? aoN[h][i] : aoC[h][i];
            PG8_LDB(B0, 0, 0); PG8_LDB(B1, 0, 1); PG8_SCHED; PG8_LDA(At, 0, 0); PG8_STAGE(PG8_SA(1, 1), a1, aoC[1]);
            PG8_WAIT_V(8); PG8_BAR; PG8_MMA2(0, At, B0, B1, PG8_WLB(6, At, B0, B1)); PG8_BAR; PG8_SCHED;
            PG8_LDA(At, 0, 1); PG8_STAGE(PG8_SB(0, 0), b2, voffB); PG8_STAGE(PG8_SB(0, 1), b2 + hstep, voffB); PG8_STAGE(PG8_SA(0, 0), a2, ao2[0]);
            PG8_WAIT_V(8); PG8_BAR; PG8_MMA2(1, At, B0, B1, PG8_WL(6, At, 0)); PG8_BAR; PG8_SCHED;
            PG8_LDB(B0, 1, 0); PG8_LDB(B1, 1, 1); PG8_SCHED; PG8_LDA(At, 1, 0); PG8_STAGE(PG8_SA(0, 1), a2, ao2[1]);
            PG8_WAIT_V(8); PG8_BAR; PG8_MMA2(0, At, B0, B1, PG8_WLB(6, At, B0, B1)); PG8_BAR; PG8_SCHED;
            PG8_LDA(At, 1, 1); PG8_STAGE(PG8_SB(1, 0), b3, voffB); PG8_STAGE(PG8_SB(1, 1), b3 + hstep, voffB); PG8_STAGE(PG8_SA(1, 0), a3, ao2[0]);
            PG8_WAIT_V(8); PG8_BAR; PG8_MMA2(1, At, B0, B1, PG8_WL(6, At, 0)); PG8_BAR; PG8_SCHED;
        }
        if (wr == 0) PG8_BAR;
        if constexpr (F8) { asm volatile("s_nop 15\n\ts_nop 15" ::: "memory"); }
        E(acc, cur, wr, wc, fr, fq);
        if (!has_next) break;
#pragma unroll
        for (int a = 0; a < 2; ++a)
#pragma unroll
            for (int b = 0; b < 2; ++b)
#pragma unroll
                for (int m = 0; m < 4; ++m)
#pragma unroll
                    for (int n = 0; n < 2; ++n) acc[a][b][m][n] = (f32x4){0.f, 0.f, 0.f, 0.f};
        cur = nxt; cA = nA; cB = nB; ++ui;
#pragma unroll
        for (int h = 0; h < 2; ++h)
#pragma unroll
            for (int i = 0; i < 2; ++i) aoC[h][i] = aoN[h][i];
        if (wr == 1) PG8_BAR;
    }
    PG8_WAIT_V(0);
    PG8_BAR;
#undef PG8_SA
#undef PG8_SB
#undef PG8_STAGE
#undef PG8_LDA
#undef PG8_LDB
#undef PG8_MMA2
#undef PG8_MFMA
#undef PG8_WL
#undef PG8_WLB
#undef PG8_DSR
#undef PG8_WAIT_V
#undef PG8_WAIT_L
#undef PG8_BAR
#undef PG8_SCHED
}
}
#define XB_TMO      128
#define XB_XCNT(j)  (256  + 64 * (j))
#define XB_XSUB(j)  (1280 + 64 * (j))
#define XB_XGEN(j)  (2304 + 64 * (j))
#define XB_TOP      3328
#define XB_TOPGEN   3392
#define XCD_BAR_WORDS 3456
#define XB_SPIN_CAP (1u << 18)

__device__ __forceinline__ unsigned xb_ld(unsigned* p)              { return __hip_atomic_load(p, __ATOMIC_RELAXED, __HIP_MEMORY_SCOPE_AGENT); }
__device__ __forceinline__ unsigned xb_add(unsigned* p, unsigned v) { return __hip_atomic_fetch_add(p, v, __ATOMIC_RELAXED, __HIP_MEMORY_SCOPE_AGENT); }
__device__ __forceinline__ unsigned xb_xcc_id() { return (unsigned)__builtin_amdgcn_s_getreg((3 << 11) | 20) & 0xFu; }
#define XB_SPIN(cond, bar) do { unsigned _sp = 0; while (cond) { __builtin_amdgcn_s_sleep(1); \
    if ((++_sp & 255u) == 0u) { if (xb_ld(&(bar)[XB_TMO])) break; if (_sp > XB_SPIN_CAP) { atomicAdd(&(bar)[XB_TMO], 1u); break; } } } } while (0)

struct XcdBarrier {
    unsigned* bar; unsigned x;
    volatile LAS unsigned* st;
};

__device__ __forceinline__ XcdBarrier xcd_barrier_post(unsigned* bar, volatile LAS unsigned* st) {
    XcdBarrier b; b.bar = bar; b.x = xb_xcc_id(); b.st = st;
    if (threadIdx.x == 0) (void)xb_add(&bar[XB_XCNT(b.x)], 1u);
    return b;
}
__device__ __forceinline__ void xcd_barrier_complete(unsigned* bar, unsigned x, unsigned& nloc, unsigned& nx) {
    const unsigned G = gridDim.x * gridDim.y * gridDim.z;
    unsigned sum, cnt, mine, sp = 0u;
    for (;;) {
        sum = 0u; cnt = 0u; mine = 0u;
#pragma unroll
        for (unsigned j = 0; j < 16; ++j) { const unsigned c = xb_ld(&bar[XB_XCNT(j)]); sum += c; cnt += (c > 0u) ? 1u : 0u; mine = (j == x) ? c : mine; }
        if (sum == G) break;
        __builtin_amdgcn_s_sleep(1);
        if ((++sp & 255u) == 0u) { if (xb_ld(&bar[XB_TMO])) break; if (sp > XB_SPIN_CAP) { atomicAdd(&bar[XB_TMO], 1u); break; } }
    }
    nloc = mine > 0u ? mine : 1u; nx = cnt > 0u ? cnt : 1u;
}

__device__ __forceinline__ void xcd_barrier(const XcdBarrier& b) {
    asm volatile("s_waitcnt vmcnt(0)" ::: "memory");
    __syncthreads();
    if (threadIdx.x == 0) {
        unsigned* bar = b.bar;
        __builtin_amdgcn_s_waitcnt(0);
        unsigned nloc = b.st[0], nx = b.st[1];
        if (nloc == 0u) { xcd_barrier_complete(bar, b.x, nloc, nx); b.st[0] = nloc; b.st[1] = nx; }
        const unsigned old = xb_add(&bar[XB_XSUB(b.x)], 1u);
        const unsigned gen = old / nloc;
        if (old + 1u == (gen + 1u) * nloc) {
            __builtin_amdgcn_fence(__ATOMIC_RELEASE, "agent");
            asm volatile("s_waitcnt vmcnt(0)" ::: "memory");
            const unsigned og = xb_add(&bar[XB_TOP], 1u);
            const unsigned tg = og / nx;
            if (og + 1u == (tg + 1u) * nx) xb_add(&bar[XB_TOPGEN], 1u);
            else XB_SPIN(xb_ld(&bar[XB_TOPGEN]) == tg, bar);
            __builtin_amdgcn_fence(__ATOMIC_ACQUIRE, "agent");
            xb_add(&bar[XB_XGEN(b.x)], 1u);
            asm volatile("s_waitcnt vmcnt(0)" ::: "memory");
        } else {
            XB_SPIN(xb_ld(&bar[XB_XGEN(b.x)]) == gen, bar);
            __builtin_amdgcn_fence(__ATOMIC_ACQUIRE, "agent");
            asm volatile("s_waitcnt vmcnt(0)" ::: "memory");
        }
    }
    __syncthreads();
}

constexpr size_t al256(size_t x) { return (x + 255) & ~(size_t)255; }
constexpr size_t WS_CTL = 0, CTL_BYTES = 65536;
constexpr size_t WS_MOD = WS_CTL + CTL_BYTES;
constexpr size_t WS_ROPEA = al256(WS_MOD + (size_t)NL * NSEQ * 6144 * 4);
constexpr size_t WS_ROPEC = WS_ROPEA + (size_t)T * 4 * 8;
constexpr size_t WS_ROPEB = WS_ROPEC + (size_t)T * 8 * 8;
constexpr size_t WS_WIN_T = WS_ROPEB + (size_t)T * 16 * 8;
constexpr size_t WS_WUQ_T = WS_WIN_T + (size_t)NL * N1 * D * 2;
constexpr size_t WS_WUKV_T = WS_WUQ_T + (size_t)NL * 384 * 192 * 2;
constexpr size_t WS_WOUT_T = WS_WUKV_T + (size_t)NL * 512 * 128 * 2;
constexpr size_t WS_WGU_T = WS_WOUT_T + (size_t)NL * D * D * 2;
constexpr size_t WS_WD_T = WS_WGU_T + (size_t)NL * NE * 2 * FF * D;
constexpr size_t WS_H8 = WS_WD_T + (size_t)NL * NE * D * FF;
constexpr size_t WS_HB = WS_H8 + (size_t)M * D;
constexpr size_t WS_AFFT = WS_HB + (size_t)M * D * 2;
constexpr size_t WS_SEL = WS_AFFT + (size_t)NE * M * 4;
constexpr size_t WS_IDX = WS_SEL + (size_t)NE * M * 4;
constexpr size_t WS_GATE = WS_IDX + (size_t)NROWS * 4;
constexpr size_t WS_R1 = WS_GATE + (size_t)NROWS * 4;
constexpr size_t USZ = (size_t)M * 256 * 2;
constexpr size_t WS_U = WS_R1;
constexpr size_t WS_UB = WS_U + 9 * USZ;
constexpr size_t WS_QB = WS_UB + (size_t)M * 512 * 2;
constexpr size_t WS_KB = WS_QB + (size_t)M * 384 * 2;
constexpr size_t WS_VB = WS_KB + (size_t)M * 384 * 2;
constexpr size_t WS_CAT = WS_VB + USZ;
constexpr size_t WS_END = WS_CAT + (size_t)M * D * 2;
constexpr size_t WS_MBUF = WS_R1;
constexpr size_t WS_ACT = WS_R1;
constexpr size_t WS_Y = WS_R1 + (size_t)CHUNK_PANELS * 256 * FF;
static_assert(WS_Y + (size_t)NROWS * D * 2 <= WS_END, "ws map");
static_assert(WS_MBUF + (size_t)M * D * 2 <= WS_CAT, "mbuf overlaps cat");

constexpr int LDS_BYTES = 147456;
constexpr int RING_BYTES = 131072, MISC_OFF = RING_BYTES + 320;

struct Params {
    const float* in[26];
    float* out; unsigned char* ws;
    double invA[4], invC[8], invB[16];
    float lam_init[2];
    int ph_lo, ph_hi;
};

typedef const __attribute__((address_space(4))) Params* CParams;
DI CParams launder_args() { CParams q = (CParams)__builtin_amdgcn_kernarg_segment_ptr(); asm volatile("" : "+s"(q)); return q; }
DI const float* x_in_row(CParams p, int t) { return t < MP ? p->in[0] + (size_t)t * D : p->in[1] + (size_t)(t - MP) * D; }
DI const float* x_row_of(const float* xp, const float* xs, int t) { return t < MP ? xp + (size_t)t * D : xs + (size_t)(t - MP) * D; }

template <int NS>
DI void tconv(const float* __restrict__ src, int ldn, bf16_t* __restrict__ dst, int ldk, LAS unsigned char* scr, int tid) {
    constexpr int NT = 32 * NS, F4R = NT / 4, RPP = 512 / F4R, NP = 64 / RPP, LSTR = 72;
    f32x4 v[NP];
    const int c4 = tid % F4R, r0 = tid / F4R;
#pragma unroll
    for (int p = 0; p < NP; ++p) v[p] = *(const f32x4*)(src + (size_t)(r0 + p * RPP) * ldn + 4 * c4);
    LAS bf16_t* t = (LAS bf16_t*)scr;
#pragma unroll
    for (int p = 0; p < NP; ++p) { const int k = r0 + p * RPP;
#pragma unroll
        for (int e = 0; e < 4; ++e) t[(4 * c4 + e) * LSTR + k] = (bf16_t)(pk2(v[p][e], 0.f) & 0xffffu); }
    __syncthreads();
    for (int c = tid; c < NT * 8; c += 512) { const int n = c >> 3, kc = c & 7; const u32x4 w = *(const LAS u32x4*)(t + n * LSTR + 8 * kc); *(u32x4*)(dst + (size_t)n * ldk + 8 * kc) = w; }
    __syncthreads();
}

struct ConvJob { const float* src; unsigned char* dst; int ldn, ldk; float scale; };
constexpr int CONV_JOBS_PER_LAYER = NE * 3 * 704;
DI ConvJob conv_job(CParams p, int l, int j) {
    const int e = j / 2112, r = j % 2112, ty = r / 704, q = r % 704, le = l * NE + e;
    ConvJob J;
    if (ty < 2) { const int kt = q / 44, nt = q % 44;
        J.src = p->in[23 + ty] + ((size_t)le * D + 64 * kt) * FF + 64 * nt; J.ldn = FF;
        J.scale = ty == 0 ? 256.f * LOG2E : 256.f * 0.69314718056f;
        J.dst = p->ws + WS_WGU_T + ((size_t)le * 2 * FF + 256 * (nt >> 1) + 128 * ty + 64 * (nt & 1)) * D + 64 * kt; J.ldk = D;
    } else { const int kt = q / 16, nt = q % 16;
        J.src = p->in[25] + ((size_t)le * FF + 64 * kt) * D + 64 * nt; J.ldn = D;
        J.dst = p->ws + WS_WD_T + ((size_t)le * D + 64 * nt) * FF + 64 * kt; J.ldk = FF; J.scale = 256.f; }
    return J;
}
DI void conv_load(const ConvJob& J, int lane, f32x4 (&v)[4][4]) {
    const int c4 = lane & 15, kq = lane >> 4;
#pragma unroll
    for (int i = 0; i < 4; ++i)
#pragma unroll
        for (int pp = 0; pp < 4; ++pp) v[i][pp] = __builtin_nontemporal_load((const f32x4*)(J.src + (size_t)(16 * i + 4 * kq + pp) * J.ldn + 4 * c4));
}
DI void conv_store(const ConvJob& J, int lane, const f32x4 (&v)[4][4], LAS unsigned char* scr  ) {
    constexpr int LSTR = 68;
    const int c4 = lane & 15, kq = lane >> 4;
#pragma unroll
    for (int i = 0; i < 4; ++i)
#pragma unroll
        for (int e = 0; e < 4; ++e) { int w = 0; w = __builtin_amdgcn_cvt_pk_fp8_f32(v[i][0][e] * J.scale, v[i][1][e] * J.scale, w, false); w = __builtin_amdgcn_cvt_pk_fp8_f32(v[i][2][e] * J.scale, v[i][3][e] * J.scale, w, true);
            *(LAS int*)(scr + (4 * c4 + e) * LSTR + 16 * i + 4 * kq) = w; }
    LDS_WAIT();
#pragma unroll
    for (int jn = 0; jn < 4; ++jn) { const int n = 16 * jn + (lane >> 2), kc = lane & 3; const LAS int* sp = (const LAS int*)(scr + n * LSTR + 16 * kc);
        const u32x4 w = {(unsigned)sp[0], (unsigned)sp[1], (unsigned)sp[2], (unsigned)sp[3]}; *(u32x4*)(J.dst + (size_t)n * J.ldk + 16 * kc) = w; }
    LDS_WAIT();
}
constexpr int CONV_EARLY = 15232;
DI void convert_experts_wave(CParams p, int l, LAS unsigned char* scr, int j0, int j1, int gw, int ngw, int lane) {
    if (j0 + gw >= j1) return;
    f32x4 v[4][4], vn[4][4];
    ConvJob J = conv_job(p, l, j0 + gw), Jn = J;
    conv_load(J, lane, v);
#pragma unroll 1
    for (int j = j0 + gw; j < j1; j += ngw) {
        const bool more = j + ngw < j1;
        if (more) { Jn = conv_job(p, l, j + ngw); conv_load(Jn, lane, vn); }
        conv_store(J, lane, v, scr);
        if (more) { J = Jn;
#pragma unroll
            for (int i = 0; i < 4; ++i)
#pragma unroll
                for (int q = 0; q < 4; ++q) v[i][q] = vn[i][q]; }
    }
}

DI int win_dst_row(int sb) {
    const int c = 32 * sb;
    if (c < 768) return c;
    if (c < 960) return 2304 + (c - 768);
    if (c < 1088) return 2560 + (c - 960);
    if (c < 1120) return 2688 + (c - 1088);
    return 768 + (c - 1120);
}

DI void prologue_a(CParams p, LAS unsigned char* lds, int tid, int wg, int G) {
    const int lane = tid & 63, wave = tid >> 6;
    if (wg < (NL * 6144) / 48) {
        LAS float* sc = (LAS float*)lds;
        LAS float* red = (LAS float*)(lds + 81920);
        for (int i = tid; i < NSEQ * D; i += 512) { const int b = i >> 10, k = i & 1023; const float c = b < 4 ? p->in[2][b * D + k] : p->in[3][(b - 4) * D + k]; sc[i] = c / (1.f + __expf(-c)); }
        __syncthreads();
        const int l = (wg * 48) / 6144, j0 = (wg * 48) % 6144, ln48 = lane < 48 ? lane : 47;
        const float* W = p->in[16] + (size_t)l * D * 6144 + j0 + ln48;
        float acc[NSEQ];
#pragma unroll
        for (int b = 0; b < NSEQ; ++b) acc[b] = 0.f;
#pragma unroll 1
        for (int k0 = wave * 128; k0 < wave * 128 + 128; k0 += 16) {
            float w[16];
#pragma unroll
            for (int kk = 0; kk < 16; ++kk) w[kk] = W[(size_t)(k0 + kk) * 6144];
#pragma unroll
            for (int k4 = 0; k4 < 4; ++k4) { asm volatile("" ::: "memory");
#pragma unroll
                for (int b = 0; b < NSEQ; ++b) { const f32x4 s = *(const LAS f32x4*)(sc + b * D + k0 + 4 * k4); acc[b] += s[0] * w[4 * k4] + s[1] * w[4 * k4 + 1] + s[2] * w[4 * k4 + 2] + s[3] * w[4 * k4 + 3]; } }
        }
#pragma unroll
        for (int b = 0; b < NSEQ; ++b) red[(wave * NSEQ + b) * 64 + lane] = acc[b];
        __syncthreads();
        float* MOD = (float*)(p->ws + WS_MOD);
        for (int i = tid; i < NSEQ * 64; i += 512) { const int b = i >> 6, ln = i & 63; if (ln >= 48) continue; float s = 0.f;
#pragma unroll
            for (int w = 0; w < 8; ++w) s += red[(w * NSEQ + b) * 64 + ln];
            MOD[((size_t)l * NSEQ + b) * 6144 + j0 + ln] = s + p->in[17][l * 6144 + j0 + ln]; }
        __syncthreads();
    }
    {
        bf16_t* WI = (bf16_t*)(p->ws + WS_WIN_T);
        const int gt = wg * 512 + tid, GT = G * 512;
        for (int i = gt; i < NL * 160 * (D / 8); i += GT) { const int l = i / (160 * 128), q = i % (160 * 128), rr = q >> 7, c8 = q & 127; const int row = rr < 64 ? 2496 + rr : 2720 + (rr - 64);
            *(u32x4*)(WI + ((size_t)l * N1 + row) * D + 8 * c8) = (u32x4){0u, 0u, 0u, 0u}; }
        bf16_t* WUQ = (bf16_t*)(p->ws + WS_WUQ_T); bf16_t* WUKV = (bf16_t*)(p->ws + WS_WUKV_T);
        for (int i = gt; i < NL * 384 * 192; i += GT) { const int l = i / (384 * 192), q = i % (384 * 192), n = q / 192, k = q % 192;
            WUQ[i] = (bf16_t)(pk2(p->in[5][((size_t)l * 192 + k) * 384 + n] * p->in[7][l * 192 + k], 0.f) & 0xffffu); }
        for (int i = gt; i < NL * 512 * 128; i += GT) { const int l = i / (512 * 128), q = i % (512 * 128), n = q / 128, k = q % 128;
            WUKV[i] = (bf16_t)(pk2(p->in[6][((size_t)l * 128 + k) * 512 + n] * p->in[8][l * 128 + k], 0.f) & 0xffffu); }
        f32x2* RA = (f32x2*)(p->ws + WS_ROPEA); f32x2* RC = (f32x2*)(p->ws + WS_ROPEC); f32x2* RB = (f32x2*)(p->ws + WS_ROPEB);
        for (int i = gt; i < T * 28; i += GT) { const int pos = i / 28, j = i % 28;
            const double inv = j < 4 ? p->invA[j] : j < 12 ? p->invC[j - 4] : p->invB[j - 12];
            double rev = (double)pos * inv * 0.15915494309189533577; rev -= __builtin_rint(rev);
            const float fr = (float)rev; const f32x2 cs = {__builtin_amdgcn_cosf(fr), __builtin_amdgcn_sinf(fr)};
            if (j < 4) RA[pos * 4 + j] = cs; else if (j < 12) RC[pos * 8 + (j - 4)] = cs; else RB[pos * 16 + (j - 12)] = cs; }
    }
}

constexpr int WCONV_JOBS = NL * 16 * 83 + NL * 16 * 32;
DI void wconv_job(CParams p, int j, int lane, LAS unsigned char* scr  ) {
    const float* src; bf16_t* dst; int ldn;
    if (j < NL * 16 * 83) { const int l = j / (16 * 83), q = j % (16 * 83), kt = q / 83, sb = q % 83;
        src = p->in[4] + ((size_t)l * D + 64 * kt) * 2656 + 32 * sb; ldn = 2656; dst = (bf16_t*)(p->ws + WS_WIN_T) + ((size_t)l * N1 + win_dst_row(sb)) * D + 64 * kt; }
    else { const int j2 = j - NL * 16 * 83, l = j2 >> 9, q = j2 & 511, kt = q >> 5, nb = q & 31;
        src = p->in[15] + ((size_t)l * D + 64 * kt) * D + 32 * nb; ldn = D; dst = (bf16_t*)(p->ws + WS_WOUT_T) + ((size_t)l * D + 32 * nb) * D + 64 * kt; }
    const int c4 = lane & 7, kq = lane >> 3;
    f32x4 v[2][4];
#pragma unroll
    for (int i = 0; i < 2; ++i)
#pragma unroll
        for (int pp = 0; pp < 4; ++pp) v[i][pp] = __builtin_nontemporal_load((const f32x4*)(src + (size_t)(32 * i + 4 * kq + pp) * ldn + 4 * c4));
    constexpr int LSTR = 136;
#pragma unroll
    for (int i = 0; i < 2; ++i)
#pragma unroll
        for (int e = 0; e < 4; ++e) { u32x2 w; w.x = pk2(v[i][0][e], v[i][1][e]); w.y = pk2(v[i][2][e], v[i][3][e]); *(LAS u32x2*)(scr + (4 * c4 + e) * LSTR + 64 * i + 8 * kq) = w; }
    LDS_WAIT();
#pragma unroll
    for (int jn = 0; jn < 4; ++jn) { const int n = 8 * jn + (lane >> 3), kc = lane & 7; const LAS u32x2* sp = (const LAS u32x2*)(scr + n * LSTR + 16 * kc);
        const u32x2 lo = sp[0], hi = sp[1]; *(u32x4*)(dst + (size_t)n * D + 8 * kc) = (u32x4){lo.x, lo.y, hi.x, hi.y}; }
    LDS_WAIT();
}
DI void prologue_b(CParams p, LAS unsigned char* lds, int tid, int wg, int G) {
    const int lane = tid & 63, gw = wg * NWAVES + (tid >> 6), NGW = G * NWAVES;
    for (int j = gw; j < WCONV_JOBS; j += NGW) wconv_job(p, j, lane, lds + (tid >> 6) * 4352);
    const float* MOD = (const float*)(p->ws + WS_MOD); bf16_t* HB = (bf16_t*)(p->ws + WS_HB);
    const int per = (((M + NGW - 1) / NGW) + 3) & ~3; const int t0 = gw * per, t1 = (t0 + per < M) ? t0 + per : M;
    int curb = -1; f32x4 scp[4], shp[4];
    const float* xin_p = p->in[0]; const float* xin_s = p->in[1];
    for (int t = t0; t < t1; t += 4) {
        const int b = t >> 12;
        if (b != curb) { curb = b; const float* mb = MOD + (size_t)b * 6144;
#pragma unroll
            for (int j = 0; j < 4; ++j) { shp[j] = *(const f32x4*)(mb + 4 * lane + 256 * j); scp[j] = *(const f32x4*)(mb + 1024 + 4 * lane + 256 * j) + 1.f; } }
        const float* xr = x_row_of(xin_p, xin_s, t);
        f32x4 x[4][4];
#pragma unroll
        for (int r = 0; r < 4; ++r)
#pragma unroll
            for (int j = 0; j < 4; ++j) x[r][j] = __builtin_nontemporal_load((const f32x4*)(xr + (size_t)r * D + 4 * lane + 256 * j));
#pragma unroll
        for (int r = 0; r < 4; ++r)
#pragma unroll
            for (int j = 0; j < 4; ++j) { const f32x4 h = x[r][j] * scp[j] + shp[j];
                u32x2 w; w.x = pk2(h[0], h[1]); w.y = pk2(h[2], h[3]); *(u32x2*)(HB + (size_t)(t + r) * D + 4 * lane + 256 * j) = w; }
    }
}
namespace pg8 {
struct ProbPlain {
    static constexpr bool GATHER = false, FP8 = false; static constexpr int SCALE_A = 0x7f7f7f7f, SCALE_B = 0x7f7f7f7f;
    const bf16_t* A; const bf16_t* Bt; int K;
    DI const char* a_base(const Unit& u) const { return (const char*)A + (size_t)u.pm * BM * K * 2; }
    DI unsigned a_off(const Unit&, int r) const { return (unsigned)(r * K) * 2u; }
    DI const char* b_base(const Unit& u) const { return (const char*)Bt + (size_t)u.pn * BM * K * 2; }
};
DI int panel_expert(int panel) { return panel < 128 ? (panel >> 3) : ((panel - 128) >> 5); }
struct ProbMoeUp {
    static constexpr bool GATHER = true, FP8 = true; static constexpr int SCALE_A = 0x7f7f7f7f, SCALE_B = 0x77777777;
    const unsigned char* H; const unsigned char* WGU; const int* idx; int chunk; int K;
    DI const char* a_base(const Unit&) const { return (const char*)H; }
    DI unsigned a_off(const Unit& u, int r) const { return (unsigned)idx[(chunk * CHUNK_PANELS + u.pm) * BM + r] * (unsigned)D; }
    DI const int* idx_ptr(const Unit& u, int r) const { return idx + (chunk * CHUNK_PANELS + u.pm) * BM + r; }
    DI unsigned off_of_idx(int ix) const { return (unsigned)ix * (unsigned)D; }
    DI const char* b_base(const Unit& u) const { return (const char*)WGU + ((size_t)panel_expert(chunk * CHUNK_PANELS + u.pm) * 2 * FF + (size_t)u.pn * BM) * D; }
};
struct ProbMoeDown {
    static constexpr bool GATHER = false, FP8 = true; static constexpr int SCALE_A = 0x7f7f7f7f, SCALE_B = 0x77777777;
    const unsigned char* ACT; const unsigned char* WD; int chunk; int K;
    DI const char* a_base(const Unit& u) const { return (const char*)ACT + (size_t)u.pm * BM * FF; }
    DI unsigned a_off(const Unit&, int r) const { return (unsigned)(r * FF); }
    DI const char* b_base(const Unit& u) const { return (const char*)WD + ((size_t)panel_expert(chunk * CHUNK_PANELS + u.pm) * D + (size_t)u.pn * BM) * FF; }
};

struct EpiStore {
    bf16_t* O; int ldc;
    DI void operator()(const f32x4 (&acc)[2][2][4][2], const Unit& u, int wr, int wc, int fr, int fq) const {
        const int row0 = u.pm * BM + wr * 64 + fr, col0 = u.pn * BM + wc * 32 + 8 * fq;
#pragma unroll
        for (int ai = 0; ai < 2; ++ai)
#pragma unroll
            for (int m = 0; m < 4; ++m) { bf16_t* rowp = O + (size_t)(row0 + ai * HALF + m * 16) * ldc + col0;
#pragma unroll
                for (int bj = 0; bj < 2; ++bj) { const f32x4 v0 = acc[ai][bj][m][0], v1 = acc[ai][bj][m][1];
                    u32x4 w; w.x = pk2(v0[0], v0[1]); w.y = pk2(v0[2], v0[3]); w.z = pk2(v1[0], v1[1]); w.w = pk2(v1[2], v1[3]);
                    *(u32x4*)(rowp + bj * HALF) = w; } }
    }
};

struct EpiInProj {
    bf16_t* U; bf16_t* UB; const f32x2* ropeA; const f32x2* ropeC; float scA, scC;
    DI void operator()(const f32x4 (&acc)[2][2][4][2], const Unit& u, int wr, int wc, int fr, int fq) const {
        const int pn = u.pn;
        bf16_t* base; int ldc, colt;
        if (pn < 9) { base = U + (size_t)pn * M * 256; ldc = 256; colt = 0; } else { base = UB; ldc = 512; colt = (pn - 9) * 256; }
        const float sc = (pn == 0) ? scA : ((pn == 3 || pn == 6) ? scC : 1.f);
        const int mode = (pn <= 1) ? 1 : ((pn == 3 || pn == 4) ? 2 : 0);
        const int row0 = u.pm * BM + wr * 64 + fr, col0 = colt + wc * 32 + 8 * fq;
#pragma unroll
        for (int ai = 0; ai < 2; ++ai) {
            f32x4 csb[4][4];
            if (mode == 1) {
#pragma unroll
                for (int m = 0; m < 4; ++m) { const f32x4* rp = (const f32x4*)(ropeA + ((row0 + ai * HALF + m * 16) & (T - 1)) * 4); csb[m][0] = rp[0]; csb[m][1] = rp[1]; }
            } else if (mode == 2) {
#pragma unroll
                for (int m = 0; m < 4; ++m) { const f32x4* rp = (const f32x4*)(ropeC + ((row0 + ai * HALF + m * 16) & (T - 1)) * 8); csb[m][0] = rp[0]; csb[m][1] = rp[1]; csb[m][2] = rp[2]; csb[m][3] = rp[3]; }
            }
#pragma unroll
            for (int m = 0; m < 4; ++m) {
                const int row = row0 + ai * HALF + m * 16;
                f32x4 cs[4];
                cs[0] = csb[m][0]; cs[1] = csb[m][1]; cs[2] = mode == 1 ? csb[m][0] : csb[m][2]; cs[3] = mode == 1 ? csb[m][1] : csb[m][3];
#pragma unroll
                for (int bj = 0; bj < 2; ++bj) {
                    f32x4 v0 = acc[ai][bj][m][0], v1 = acc[ai][bj][m][1];
                    if (mode == 1) {
                        if (fq == 0) {
#pragma unroll
                            for (int e = 0; e < 4; ++e) { const float c = cs[e >> 1][2 * (e & 1)], s = cs[e >> 1][2 * (e & 1) + 1]; const float x1 = v0[e], x2 = v1[e]; v0[e] = x1 * c - x2 * s; v1[e] = x2 * c + x1 * s; }
                        }
                    } else if (mode == 2) {
                        if ((wc & 1) == 0) {
                            f32x4 o0, o1;
#pragma unroll
                            for (int e = 0; e < 4; ++e) { o0[e] = __shfl_xor(v0[e], 16); o1[e] = __shfl_xor(v1[e], 16); }
                            if (fq < 2) {
                                const float sg = fq == 0 ? -1.f : 1.f;
#pragma unroll
                                for (int e = 0; e < 4; ++e) {
                                    const float c0 = cs[e >> 1][2 * (e & 1)], s0 = cs[e >> 1][2 * (e & 1) + 1];
                                    const float c1 = cs[2 + (e >> 1)][2 * (e & 1)], s1 = cs[2 + (e >> 1)][2 * (e & 1) + 1];
                                    v0[e] = v0[e] * c0 + sg * o0[e] * s0; v1[e] = v1[e] * c1 + sg * o1[e] * s1; }
                            }
                        }
                    }
                    v0 = v0 * sc; v1 = v1 * sc;
                    u32x4 w; w.x = pk2(v0[0], v0[1]); w.y = pk2(v0[2], v0[3]); w.z = pk2(v1[0], v1[1]); w.w = pk2(v1[2], v1[3]);
                    *(u32x4*)(base + (size_t)row * ldc + col0 + bj * HALF) = w;
                }
            }
        }
    }
};

DI unsigned pk4_fp8(float a, float b, float c, float d) { int w = 0; w = __builtin_amdgcn_cvt_pk_fp8_f32(a, b, w, false); w = __builtin_amdgcn_cvt_pk_fp8_f32(c, d, w, true); return (unsigned)w; }
struct EpiSwiGLU {
    unsigned char* ACT;
    DI void operator()(const f32x4 (&acc)[2][2][4][2], const Unit& u, int wr, int wc, int fr, int fq) const {
        const int row0 = u.pm * BM + wr * 64 + fr, col0 = u.pn * HALF + wc * 32 + 8 * fq;
#pragma unroll
        for (int ai = 0; ai < 2; ++ai)
#pragma unroll
            for (int m = 0; m < 4; ++m) {
                f32x4 r[2];
#pragma unroll
                for (int n = 0; n < 2; ++n) { const f32x4 g = acc[ai][0][m][n], up = acc[ai][1][m][n];
                    f32x4 ex, rc;
#pragma unroll
                    for (int e = 0; e < 4; ++e) ex[e] = __builtin_amdgcn_exp2f(-g[e]);
                    const f32x4 den = ex + 1.f;
#pragma unroll
                    for (int e = 0; e < 4; ++e) rc[e] = __builtin_amdgcn_rcpf(den[e]);
                    r[n] = (g * up) * rc; }
                u32x2 w; w.x = pk4_fp8(r[0][0], r[0][1], r[0][2], r[0][3]); w.y = pk4_fp8(r[1][0], r[1][1], r[1][2], r[1][3]);
                *(u32x2*)(ACT + (size_t)(row0 + ai * HALF + m * 16) * FF + col0) = w;
            }
    }
};

struct EpiDown {
    bf16_t* Y; const float* gate; int chunk;
    DI void operator()(const f32x4 (&acc)[2][2][4][2], const Unit& u, int wr, int wc, int fr, int fq) const {
        const int row0 = (chunk * CHUNK_PANELS + u.pm) * BM + wr * 64 + fr, col0 = u.pn * BM + wc * 32 + 8 * fq;
        float gv[2][4];
#pragma unroll
        for (int ai = 0; ai < 2; ++ai)
#pragma unroll
            for (int m = 0; m < 4; ++m) gv[ai][m] = gate[row0 + ai * HALF + m * 16];
        __builtin_amdgcn_sched_barrier(0);
#pragma unroll
        for (int ai = 0; ai < 2; ++ai)
#pragma unroll
            for (int m = 0; m < 4; ++m) { const int row = row0 + ai * HALF + m * 16; const float g = gv[ai][m]; bf16_t* rowp = Y + (size_t)row * D + col0;
#pragma unroll
                for (int bj = 0; bj < 2; ++bj) { const f32x4 v0 = acc[ai][bj][m][0] * g, v1 = acc[ai][bj][m][1] * g;
                    u32x4 w; w.x = pk2(v0[0], v0[1]); w.y = pk2(v0[2], v0[3]); w.z = pk2(v1[0], v1[1]); w.w = pk2(v1[2], v1[3]);
                    *(u32x4*)(rowp + bj * HALF) = w; } }
    }
};
}
DI void mla_phase(CParams p, int l, LAS unsigned char* lds, int tid, int wg, int G) {
    const int lane = tid & 63, wave = __builtin_amdgcn_readfirstlane(tid >> 6);
    const int j16 = lane & 15, kq = lane >> 4;
    const bf16_t* UB = (const bf16_t*)(p->ws + WS_UB);
    const bf16_t* WUQ = (const bf16_t*)(p->ws + WS_WUQ_T) + (size_t)l * 384 * 192;
    const bf16_t* WUKV = (const bf16_t*)(p->ws + WS_WUKV_T) + (size_t)l * 512 * 128;
    const f32x2* RB = (const f32x2*)(p->ws + WS_ROPEB);
    bf16_t* QB = (bf16_t*)(p->ws + WS_QB); bf16_t* KB = (bf16_t*)(p->ws + WS_KB); bf16_t* VB = (bf16_t*)(p->ws + WS_VB);
    const float qscale = 0.10206207261596575f * LOG2E;
    constexpr int QP = 400, KP = 272;
    for (int task = wg; task < 4 * (M / 256); task += G) {
        const int part = ((G & 3) == 0 ? task + task / G : task) & 3, tok0 = (task >> 2) * 256 + wave * 32;
        __syncthreads();
        if (part < 2) {
            for (int c = wave; c < 75; c += NWAVES) { const int L = c * 64 + lane, row = L / 25, cc = L - row * 25;
                __builtin_amdgcn_global_load_lds((const unsigned*)(WUQ + (size_t)(192 * part + row) * 192 + (cc < 24 ? cc : 0) * 8), (LAS unsigned*)(lds + c * 1024), 16, 0, 0); }
        } else {
            for (int c = wave; c < 68; c += NWAVES) { const int L = c * 64 + lane, row = L / 17, cc = L - row * 17;
                __builtin_amdgcn_global_load_lds((const unsigned*)(WUKV + (size_t)(256 * (part - 2) + row) * 128 + (cc < 16 ? cc : 0) * 8), (LAS unsigned*)(lds + c * 1024), 16, 0, 0); }
        }
        if (part < 2) {
            bf16x8 xf[2][6]; float rs[2];
#pragma unroll
            for (int rt = 0; rt < 2; ++rt)
#pragma unroll
                for (int s = 0; s < 6; ++s) xf[rt][s] = __builtin_bit_cast(bf16x8, *(const u32x4*)(UB + (size_t)(tok0 + 16 * rt + j16) * 512 + 32 * s + 8 * kq));
            __builtin_amdgcn_sched_barrier(0);
#pragma unroll
            for (int rt = 0; rt < 2; ++rt) { float ss = 0.f;
#pragma unroll
                for (int s = 0; s < 6; ++s) { const u32x4 w = __builtin_bit_cast(u32x4, xf[rt][s]);
#pragma unroll
                    for (int e = 0; e < 4; ++e) { const float a = bf_lo(w[e]), b = bf_hi(w[e]); ss += a * a + b * b; } }
                ss += __shfl_xor(ss, 16); ss += __shfl_xor(ss, 32);
                rs[rt] = __builtin_amdgcn_rsqf(ss * (1.f / 192.f) + RMS_EPS) * qscale; }
            f32x4 rc01[2], rc23[2];
#pragma unroll
            for (int rt = 0; rt < 2; ++rt) { const f32x4* rp = (const f32x4*)(RB + (size_t)((tok0 + 16 * rt + j16) & (T - 1)) * 16 + 4 * kq); rc01[rt] = rp[0]; rc23[rt] = rp[1]; }
            asm volatile("s_waitcnt vmcnt(0)" ::: "memory"); __syncthreads();
#pragma unroll 1
            for (int npl = 0; npl < 6; ++npl) { const int np = 6 * part + npl;
                bf16x8 W[6][2];
#pragma unroll
                for (int s_ = 0; s_ < 6; ++s_)
#pragma unroll
                    for (int nn = 0; nn < 2; ++nn) W[s_][nn] = *(const LAS bf16x8*)(lds + (32 * npl + 16 * nn + j16) * QP + 64 * s_ + 16 * kq);
                f32x4 acc[2][2];
#pragma unroll
                for (int a2 = 0; a2 < 2; ++a2)
#pragma unroll
                    for (int b2 = 0; b2 < 2; ++b2) acc[a2][b2] = (f32x4){0.f, 0.f, 0.f, 0.f};
#pragma unroll
                for (int s_ = 0; s_ < 6; ++s_)
#pragma unroll
                    for (int nn = 0; nn < 2; ++nn)
#pragma unroll
                        for (int rt = 0; rt < 2; ++rt) acc[rt][nn] = __builtin_amdgcn_mfma_f32_16x16x32_bf16(W[s_][nn], xf[rt][s_], acc[rt][nn], 0, 0, 0);
                const bool rope = (np % 3) == 2;
#pragma unroll
                for (int rt = 0; rt < 2; ++rt) { const int tok = tok0 + 16 * rt + j16;
                    f32x4 v0 = acc[rt][0] * rs[rt], v1 = acc[rt][1] * rs[rt];
                    if (rope) { const f32x4 c01 = rc01[rt], c23 = rc23[rt];
#pragma unroll
                        for (int e = 0; e < 4; ++e) { const float c = (e < 2 ? c01 : c23)[2 * (e & 1)], sn = (e < 2 ? c01 : c23)[2 * (e & 1) + 1]; const float x1 = v0[e], x2 = v1[e]; v0[e] = x1 * c - x2 * sn; v1[e] = x2 * c + x1 * sn; } }
                    u32x2 w0, w1; w0.x = pk2(v0[0], v0[1]); w0.y = pk2(v0[2], v0[3]); w1.x = pk2(v1[0], v1[1]); w1.y = pk2(v1[2], v1[3]);
                    *(u32x2*)(QB + (size_t)tok * 384 + 32 * np + 4 * kq) = w0; *(u32x2*)(QB + (size_t)tok * 384 + 32 * np + 16 + 4 * kq) = w1; }
            }
        }
        else {
            bf16x8 xf[2][4]; float rs[2];
#pragma unroll
            for (int rt = 0; rt < 2; ++rt)
#pragma unroll
                for (int s = 0; s < 4; ++s) xf[rt][s] = __builtin_bit_cast(bf16x8, *(const u32x4*)(UB + (size_t)(tok0 + 16 * rt + j16) * 512 + 256 + 32 * s + 8 * kq));
            __builtin_amdgcn_sched_barrier(0);
#pragma unroll
            for (int rt = 0; rt < 2; ++rt) { float ss = 0.f;
#pragma unroll
                for (int s = 0; s < 4; ++s) { const u32x4 w = __builtin_bit_cast(u32x4, xf[rt][s]);
#pragma unroll
                    for (int e = 0; e < 4; ++e) { const float a = bf_lo(w[e]), b = bf_hi(w[e]); ss += a * a + b * b; } }
                ss += __shfl_xor(ss, 16); ss += __shfl_xor(ss, 32);
                rs[rt] = __builtin_amdgcn_rsqf(ss * (1.f / 128.f) + RMS_EPS); }
            asm volatile("s_waitcnt vmcnt(0)" ::: "memory"); __syncthreads();
#pragma unroll 1
            for (int npl = 0; npl < 8; ++npl) { const int np = 8 * (part - 2) + npl;
                bf16x8 W[4][2];
#pragma unroll
                for (int s_ = 0; s_ < 4; ++s_)
#pragma unroll
                    for (int nn = 0; nn < 2; ++nn) W[s_][nn] = *(const LAS bf16x8*)(lds + (32 * npl + 16 * nn + j16) * KP + 64 * s_ + 16 * kq);
                f32x4 acc[2][2];
#pragma unroll
                for (int a2 = 0; a2 < 2; ++a2)
#pragma unroll
                    for (int b2 = 0; b2 < 2; ++b2) acc[a2][b2] = (f32x4){0.f, 0.f, 0.f, 0.f};
#pragma unroll
                for (int s_ = 0; s_ < 4; ++s_)
#pragma unroll
                    for (int nn = 0; nn < 2; ++nn)
#pragma unroll
                        for (int rt = 0; rt < 2; ++rt) acc[rt][nn] = __builtin_amdgcn_mfma_f32_16x16x32_bf16(W[s_][nn], xf[rt][s_], acc[rt][nn], 0, 0, 0);
                const int n0 = 32 * np, h = n0 >> 7, within = n0 & 127;
#pragma unroll
                for (int rt = 0; rt < 2; ++rt) { const int tok = tok0 + 16 * rt + j16;
                    const f32x4 v0 = acc[rt][0] * rs[rt], v1 = acc[rt][1] * rs[rt];
                    u32x2 w0, w1; w0.x = pk2(v0[0], v0[1]); w0.y = pk2(v0[2], v0[3]); w1.x = pk2(v1[0], v1[1]); w1.y = pk2(v1[2], v1[3]);
                    bf16_t* dst = within < 64 ? KB + (size_t)tok * 384 + 96 * h + within : VB + (size_t)tok * 256 + 64 * h + (within - 64);
                    *(u32x2*)(dst + 4 * kq) = w0; *(u32x2*)(dst + 16 + 4 * kq) = w1; }
            }
            if (part == 3)
#pragma unroll
            for (int rt = 0; rt < 2; ++rt) { const int tok = tok0 + 16 * rt + j16;
                const u32x2 a = *(const u32x2*)(UB + (size_t)tok * 512 + 384 + 4 * kq), b = *(const u32x2*)(UB + (size_t)tok * 512 + 384 + 16 + 4 * kq);
                float x1[4] = {bf_lo(a.x), bf_hi(a.x), bf_lo(a.y), bf_hi(a.y)}, x2[4] = {bf_lo(b.x), bf_hi(b.x), bf_lo(b.y), bf_hi(b.y)};
                const f32x4* rp = (const f32x4*)(RB + (size_t)(tok & (T - 1)) * 16 + 4 * kq); const f32x4 c01 = rp[0], c23 = rp[1];
                float y1[4], y2[4];
#pragma unroll
                for (int e = 0; e < 4; ++e) { const float c = (e < 2 ? c01 : c23)[2 * (e & 1)], s = (e < 2 ? c01 : c23)[2 * (e & 1) + 1]; y1[e] = x1[e] * c - x2[e] * s; y2[e] = x2[e] * c + x1[e] * s; }
                u32x2 w0, w1; w0.x = pk2(y1[0], y1[1]); w0.y = pk2(y1[2], y1[3]); w1.x = pk2(y2[0], y2[1]); w1.y = pk2(y2[2], y2[3]);
#pragma unroll
                for (int h = 0; h < 4; ++h) { *(u32x2*)(KB + (size_t)tok * 384 + 96 * h + 64 + 4 * kq) = w0; *(u32x2*)(KB + (size_t)tok * 384 + 96 * h + 80 + 4 * kq) = w1; } }
        }
    }
    __syncthreads();
}

DI f32x16 mfma32(bf16x8 a, bf16x8 b, f32x16 c) { return __builtin_amdgcn_mfma_f32_32x32x16_bf16(a, b, c, 0, 0, 0); }
DI bf16x8 tr_pair(const LAS unsigned char* p0, const LAS unsigned char* p1) {
    const s16x4 lo = __builtin_amdgcn_ds_read_tr16_b64_v4i16((LAS s16x4*)p0), hi = __builtin_amdgcn_ds_read_tr16_b64_v4i16((LAS s16x4*)p1);
    return __builtin_shufflevector(lo, hi, 0, 1, 2, 3, 4, 5, 6, 7);
}
DI int crow(int i, int hh) { return (i & 3) + 8 * (i >> 2) + 4 * hh; }
constexpr float SM_THR = 8.f;
DI void softmax_step(f32x16& s, float& m, float& l, f32x16& O0, f32x16& O1, bf16x8& p0, bf16x8& p1) {
    float bm = s[0];
#pragma unroll
    for (int i = 1; i < 16; ++i) bm = fmaxf(bm, s[i]);
    bm = fmaxf(bm, __shfl_xor(bm, 32));
    if (!__all(bm <= m + SM_THR)) { const float mn = fmaxf(m, bm), al = __builtin_amdgcn_exp2f(m - mn); O0 = O0 * al; O1 = O1 * al; l *= al; m = mn; }
    float sum = 0.f;
#pragma unroll
    for (int i = 0; i < 16; ++i) { s[i] = __builtin_amdgcn_exp2f(s[i] - m); sum += s[i]; }
    l += sum;
    u32x4 a, b;
    a.x = pk2(s[0], s[1]); a.y = pk2(s[2], s[3]); a.z = pk2(s[4], s[5]); a.w = pk2(s[6], s[7]);
    b.x = pk2(s[8], s[9]); b.y = pk2(s[10], s[11]); b.z = pk2(s[12], s[13]); b.w = pk2(s[14], s[15]);
    p0 = __builtin_bit_cast(bf16x8, a); p1 = __builtin_bit_cast(bf16x8, b);
}
DI void softmax_local(f32x16& s, float& m, float& l, f32x16& O0, f32x16& O1, bf16x8& p0, bf16x8& p1) {
    float mx = fmaxf(fmaxf(s[0], s[1]), s[2]);
#pragma unroll
    for (int i = 3; i < 15; i += 2) mx = fmaxf(fmaxf(mx, s[i]), s[i + 1]);
    mx = fmaxf(mx, s[15]);
    if (__any(mx > m + SM_THR)) {
        mx = fmaxf(mx, __shfl_xor(mx, 32));
        const float mn = fmaxf(m, mx), al = __builtin_amdgcn_exp2f(m - mn); O0 = O0 * al; O1 = O1 * al; l *= al; m = mn; }
    float sum = 0.f;
#pragma unroll
    for (int i = 0; i < 16; ++i) { s[i] = __builtin_amdgcn_exp2f(s[i] - m); sum += s[i]; }
    l += sum;
    u32x4 a, b;
    a.x = pk2(s[0], s[1]); a.y = pk2(s[2], s[3]); a.z = pk2(s[4], s[5]); a.w = pk2(s[6], s[7]);
    b.x = pk2(s[8], s[9]); b.y = pk2(s[10], s[11]); b.z = pk2(s[12], s[13]); b.w = pk2(s[14], s[15]);
    p0 = __builtin_bit_cast(bf16x8, a); p1 = __builtin_bit_cast(bf16x8, b);
}
DI unsigned tr_lane_off(int lane) { const int i16 = lane & 15; return (unsigned)((4 * (lane >> 5) + (i16 >> 2)) * 64 + (16 * ((lane >> 4) & 1) + 4 * (i16 & 3)) * 2); }

template <bool QUANT>
DI void softmax_tile(f32x16& s0, f32x16& s1, float& m, float& l, f32x16& O0, f32x16& O1, bool first, bf16x8 (&pk)[4], f32x16& negm) {
    int mi = __float_as_int(s0[0]);
#pragma unroll
    for (int i = 1; i < 16; ++i) { const int a = __float_as_int(s0[i]); mi = mi > a ? mi : a; }
#pragma unroll
    for (int i = 0; i < 16; ++i) { const int a = __float_as_int(s1[i]); mi = mi > a ? mi : a; }
    if (first || __any(mi > 0x41000000  )) {
        float mx = fmaxf(s0[0], s1[0]);
#pragma unroll
        for (int i = 1; i < 16; ++i) mx = fmaxf(mx, fmaxf(s0[i], s1[i]));
        mx = fmaxf(mx, __shfl_xor(mx, 32));
        const float mraw = m + (first ? mx : fmaxf(mx, 0.f));
        const float mq = QUANT ? bf_lo(pk2(mraw, 0.f) & 0xffffu) : mraw;
        const float d = mq - m;
        const float al = first ? 1.f : __builtin_amdgcn_exp2f(-d);
        O0 = O0 * al; O1 = O1 * al; l *= al; m = mq;
#pragma unroll
        for (int i = 0; i < 16; ++i) { s0[i] -= d; s1[i] -= d; if (!QUANT) negm[i] = -mq; }
    }
    float sum = 0.f;
#pragma unroll
    for (int i = 0; i < 16; ++i) { s0[i] = __builtin_amdgcn_exp2f(s0[i]); s1[i] = __builtin_amdgcn_exp2f(s1[i]); sum += s0[i] + s1[i]; }
    l += sum;
    u32x4 a;
    a.x = pk2(s0[0], s0[1]); a.y = pk2(s0[2], s0[3]); a.z = pk2(s0[4], s0[5]); a.w = pk2(s0[6], s0[7]); pk[0] = __builtin_bit_cast(bf16x8, a);
    a.x = pk2(s0[8], s0[9]); a.y = pk2(s0[10], s0[11]); a.z = pk2(s0[12], s0[13]); a.w = pk2(s0[14], s0[15]); pk[1] = __builtin_bit_cast(bf16x8, a);
    a.x = pk2(s1[0], s1[1]); a.y = pk2(s1[2], s1[3]); a.z = pk2(s1[4], s1[5]); a.w = pk2(s1[6], s1[7]); pk[2] = __builtin_bit_cast(bf16x8, a);
    a.x = pk2(s1[8], s1[9]); a.y = pk2(s1[10], s1[11]); a.z = pk2(s1[12], s1[13]); a.w = pk2(s1[14], s1[15]); pk[3] = __builtin_bit_cast(bf16x8, a);
}
template <bool QUANT>
DI void softmax_check(f32x16& s0, f32x16& s1, float& m, float& l, f32x16& O0, f32x16& O1, bool first, f32x16& negm) {
    int mi = __float_as_int(s0[0]);
#pragma unroll
    for (int i = 1; i < 16; ++i) { const int a = __float_as_int(s0[i]); mi = mi > a ? mi : a; }
#pragma unroll
    for (int i = 0; i < 16; ++i) { const int a = __float_as_int(s1[i]); mi = mi > a ? mi : a; }
    if (first || __any(mi > 0x41000000  )) {
        float mx = fmaxf(s0[0], s1[0]);
#pragma unroll
        for (int i = 1; i < 16; ++i) mx = fmaxf(mx, fmaxf(s0[i], s1[i]));
        mx = fmaxf(mx, __shfl_xor(mx, 32));
        const float mraw = m + (first ? mx : fmaxf(mx, 0.f));
        const float mq = QUANT ? bf_lo(pk2(mraw, 0.f) & 0xffffu) : mraw;
        const float d = mq - m;
        const float al = first ? 1.f : __builtin_amdgcn_exp2f(-d);
        O0 = O0 * al; O1 = O1 * al; l *= al; m = mq;
#pragma unroll
        for (int i = 0; i < 16; ++i) { s0[i] -= d; s1[i] -= d; if (!QUANT) negm[i] = -mq; }
    }
}
#define ATT_EXP8(S, B, SUM, P) do { float e0_ = __builtin_amdgcn_exp2f(S[(B) + 0]), e1_ = __builtin_amdgcn_exp2f(S[(B) + 1]), e2_ = __builtin_amdgcn_exp2f(S[(B) + 2]), e3_ = __builtin_amdgcn_exp2f(S[(B) + 3]), \
        e4_ = __builtin_amdgcn_exp2f(S[(B) + 4]), e5_ = __builtin_amdgcn_exp2f(S[(B) + 5]), e6_ = __builtin_amdgcn_exp2f(S[(B) + 6]), e7_ = __builtin_amdgcn_exp2f(S[(B) + 7]); \
        SUM += ((e0_ + e1_) + (e2_ + e3_)) + ((e4_ + e5_) + (e6_ + e7_)); \
        u32x4 a_; a_.x = pk2(e0_, e1_); a_.y = pk2(e2_, e3_); a_.z = pk2(e4_, e5_); a_.w = pk2(e6_, e7_); P = __builtin_bit_cast(bf16x8, a_); } while (0)
#define ATT_SB __builtin_amdgcn_sched_barrier(0)
template <int MODE> struct AttSt {
    f32x16 Oa0, Oa1, Ob0, Ob1, sa0, sa1, nma; float ma, la, mb, lb; bf16x8 kone;
    const bf16_t* Kb; const bf16_t* Vb; unsigned ok0, ok1, ov;   int krs, wv; bool k2; unsigned xo[4]; unsigned troff; int hh;
};
#ifndef ATT_PRIO_ON
#define ATT_PRIO_ON 0
#endif
#define ATT_PRIO(x) do { if (ATT_PRIO_ON) __builtin_amdgcn_s_setprio(x); } while (0)
template <int MODE, int SC, int SN, int SP>
DI void att_tile(LAS unsigned char* lds, AttSt<MODE>& S, const bf16x8 (&q)[MODE == 0 ? 4 : 6], int j) {
    constexpr int DQ = MODE == 0 ? 64 : 96, KROW = DQ * 2, KBYTES = 64 * KROW, VBYTES = 8192, NQS = DQ / 16;
    const bool first = (j == 0);
    f32x16 zero16;
#pragma unroll
    for (int i = 0; i < 16; ++i) zero16[i] = 0.f;
    asm volatile("s_waitcnt vmcnt(0)" ::: "memory"); __builtin_amdgcn_s_barrier(); asm volatile("" ::: "memory");
    if (j + 2 < T / 64) { const size_t adv = (size_t)(j + 2) * 64;
        __builtin_amdgcn_global_load_lds((const unsigned*)((S.Kb + adv * S.krs) + S.ok0), (LAS unsigned*)(lds + SP * KBYTES + S.wv * 1024), 16, 0, 0);
        if (S.k2) __builtin_amdgcn_global_load_lds((const unsigned*)((S.Kb + adv * S.krs) + S.ok1), (LAS unsigned*)(lds + SP * KBYTES + (8 + S.wv) * 1024), 16, 0, 0);
        __builtin_amdgcn_global_load_lds((const unsigned*)((S.Vb + adv * 256) + S.ov), (LAS unsigned*)(lds + 3 * KBYTES + SP * VBYTES + S.wv * 1024), 16, 0, 0); }
    unsigned xo0 = S.xo[0]; asm volatile("" : "+v"(xo0));
#define ATT_KF(slot, blk, s) (*(const LAS bf16x8*)(lds + (slot) * KBYTES + (blk) * (32 * KROW) + (MODE == 0 ? (xo0 ^ ((unsigned)(s) << 5)) : (64 * ((s) >> 1) + S.xo[(s) & 1]))))
    const unsigned va_ = (unsigned)(size_t)lds + S.troff;
#define ATT_VLD(D0, D1, ks) do { s16x4 l0_, h0_, l1_, h1_; \
        asm volatile("ds_read_b64_tr_b16 %0, %4 offset:%5\n\tds_read_b64_tr_b16 %1, %4 offset:%6\n\tds_read_b64_tr_b16 %2, %4 offset:%7\n\tds_read_b64_tr_b16 %3, %4 offset:%8" \
                     : "=&v"(l0_), "=&v"(h0_), "=&v"(l1_), "=&v"(h1_) : "v"(va_), "n"(3 * KBYTES + SC * VBYTES + (16 * (ks)) * 64), "n"(3 * KBYTES + SC * VBYTES + (16 * (ks) + 8) * 64), \
                       "n"(3 * KBYTES + SC * VBYTES + 4096 + (16 * (ks)) * 64), "n"(3 * KBYTES + SC * VBYTES + 4096 + (16 * (ks) + 8) * 64) : "memory"); \
        D0 = __builtin_shufflevector(l0_, h0_, 0, 1, 2, 3, 4, 5, 6, 7); D1 = __builtin_shufflevector(l1_, h1_, 0, 1, 2, 3, 4, 5, 6, 7); } while (0)
#define ATT_VW2(a, b) asm volatile("s_waitcnt lgkmcnt(0)" : "+v"(a), "+v"(b) :: "memory")
#define ATT_VW8(a, b) asm volatile("s_waitcnt lgkmcnt(0)" : "+v"(a[0]), "+v"(a[1]), "+v"(a[2]), "+v"(a[3]), "+v"(b[0]), "+v"(b[1]), "+v"(b[2]), "+v"(b[3]) :: "memory")
    const int hh = S.hh;
    float sum = 0.f;
    if (MODE == 1) {
        bf16x8 vA0, vA1, vB0, vB1, pA, pB;
        bf16x8 kA0[2], kA1[2], kB0[2], kB1[2];
#pragma unroll
        for (int s = 0; s < 2; ++s) { kA0[s] = ATT_KF(SN, 0, s); kA1[s] = ATT_KF(SN, 1, s); }
        ATT_VLD(vA0, vA1, 0);
        softmax_check<false>(S.sa0, S.sa1, S.ma, S.la, S.Oa0, S.Oa1, first, S.nma);
        f32x16 sn0, sn1;
        ATT_SB;
#pragma unroll
        for (int s = 0; s < 2; ++s) { kB0[s] = ATT_KF(SN, 0, 2 + s); kB1[s] = ATT_KF(SN, 1, 2 + s); }
        sn0 = mfma32(kA0[0], q[0], S.nma); sn1 = mfma32(kA1[0], q[0], S.nma); sn0 = mfma32(kA0[1], q[1], sn0); sn1 = mfma32(kA1[1], q[1], sn1);
        ATT_EXP8(S.sa0, 0, sum, pA);
        ATT_SB;
#pragma unroll
        for (int s = 0; s < 2; ++s) { kA0[s] = ATT_KF(SN, 0, 4 + s); kA1[s] = ATT_KF(SN, 1, 4 + s); }
        ATT_VLD(vB0, vB1, 1);
        sn0 = mfma32(kB0[0], q[2], sn0); sn1 = mfma32(kB1[0], q[2], sn1); sn0 = mfma32(kB0[1], q[3], sn0); sn1 = mfma32(kB1[1], q[3], sn1);
        ATT_VW2(vA0, vA1); S.Oa0 = mfma32(vA0, pA, S.Oa0); S.Oa1 = mfma32(vA1, pA, S.Oa1);
        ATT_EXP8(S.sa0, 8, sum, pB);
        ATT_SB;
        ATT_VLD(vA0, vA1, 2);
        sn0 = mfma32(kA0[0], q[4], sn0); sn1 = mfma32(kA1[0], q[4], sn1); sn0 = mfma32(kA0[1], q[5], sn0); sn1 = mfma32(kA1[1], q[5], sn1);
        ATT_VW2(vB0, vB1); S.Oa0 = mfma32(vB0, pB, S.Oa0); S.Oa1 = mfma32(vB1, pB, S.Oa1);
        ATT_EXP8(S.sa1, 0, sum, pA);
        ATT_SB;
        ATT_VLD(vB0, vB1, 3);
        ATT_VW2(vA0, vA1); S.Oa0 = mfma32(vA0, pA, S.Oa0); S.Oa1 = mfma32(vA1, pA, S.Oa1);
        ATT_EXP8(S.sa1, 8, sum, pB);
        ATT_SB;
        ATT_VW2(vB0, vB1); S.Oa0 = mfma32(vB0, pB, S.Oa0); S.Oa1 = mfma32(vB1, pB, S.Oa1);
        S.la += sum; S.sa0 = sn0; S.sa1 = sn1;
    } else {
        bf16x8 pa[4];
        bf16x8 kf0[NQS], kf1[NQS];
#pragma unroll
        for (int s = 0; s < NQS; ++s) { kf0[s] = ATT_KF(SC, 0, s); kf1[s] = ATT_KF(SC, 1, s); }
        f32x16 sa0, sa1, sb0, sb1;
        const bf16x8 qxb = __builtin_bit_cast(bf16x8, (u32x4){hh ? 0u : (pk2(-S.mb, 0.f) & 0xffffu), 0u, 0u, 0u});
        ATT_PRIO(1);
        sb0 = mfma32(S.kone, qxb, zero16); asm volatile("" : "+v"(S.kone)); sb1 = mfma32(S.kone, qxb, zero16);
        ATT_SB;
        sa0 = mfma32(kf0[0], q[0], S.nma); sa1 = mfma32(kf1[0], q[0], S.nma); sb0 = mfma32(kf0[2], q[2], sb0); sb1 = mfma32(kf1[2], q[2], sb1);
        sa0 = mfma32(kf0[1], q[1], sa0); sa1 = mfma32(kf1[1], q[1], sa1); sb0 = mfma32(kf0[3], q[3], sb0); sb1 = mfma32(kf1[3], q[3], sb1);
        ATT_PRIO(0);
        ATT_SB;
        softmax_tile<false>(sa0, sa1, S.ma, S.la, S.Oa0, S.Oa1, first, pa, S.nma);
        ATT_SB;
        bf16x8 vf0[4], vf1[4];
#pragma unroll
        for (int ks = 0; ks < 4; ++ks) ATT_VLD(vf0[ks], vf1[ks], ks);
        ATT_VW8(vf0, vf1);
        ATT_PRIO(1);
#pragma unroll
        for (int ks = 0; ks < 4; ++ks) { S.Oa0 = mfma32(vf0[ks], pa[ks], S.Oa0); S.Oa1 = mfma32(vf1[ks], pa[ks], S.Oa1); }
        ATT_PRIO(0);
        softmax_tile<true>(sb0, sb1, S.mb, S.lb, S.Ob0, S.Ob1, first, pa, S.nma);
        ATT_SB;
        ATT_PRIO(1);
#pragma unroll
        for (int ks = 0; ks < 4; ++ks) { S.Ob0 = mfma32(vf0[ks], pa[ks], S.Ob0); S.Ob1 = mfma32(vf1[ks], pa[ks], S.Ob1); }
        ATT_PRIO(0);
    }
#undef ATT_VLD
#undef ATT_VW2
#undef ATT_VW8
}
template <int MODE, bool LATE>
DI void attn_full_unit(LAS unsigned char* lds, const bf16_t* Qg, const bf16_t* Kg, const bf16_t* Vg, int qrs, int krs, int seq0, int q0, bf16_t* outp,
                       float lam, float oscale, const float* subg, int tid) {
    constexpr int DQ = MODE == 0 ? 64 : 96, CPK = DQ / 8, KROW = DQ * 2, KBYTES = 64 * KROW, VBYTES = 8192, NQS = DQ / 16;
    const int lane = tid & 63, wave = tid >> 6, r = lane & 31, hh = lane >> 5;
    bf16x8 q[NQS];
    { const bf16_t* qp = Qg + (size_t)(seq0 + q0 + 32 * wave + r) * qrs + 8 * hh;
#pragma unroll
      for (int s = 0; s < NQS; ++s) q[s] = *(const bf16x8*)(qp + 16 * s); }
    AttSt<MODE> S;
    S.ma = 0.f; S.la = 0.f; S.mb = 0.f; S.lb = 0.f; S.hh = hh; S.krs = krs;
#pragma unroll
    for (int i = 0; i < 16; ++i) { S.Oa0[i] = 0.f; S.Oa1[i] = 0.f; S.Ob0[i] = 0.f; S.Ob1[i] = 0.f; S.sa0[i] = 0.f; S.sa1[i] = 0.f; S.nma[i] = 0.f; }
    S.kone = __builtin_bit_cast(bf16x8, (u32x4){hh ? 0u : 0x3f80u, 0u, 0u, 0u});
    const int wv = __builtin_amdgcn_readfirstlane(wave);
    const int c0 = 64 * wv + lane, key0 = c0 / CPK, sl0 = c0 % CPK, pt0 = MODE == 0 ? (sl0 ^ ((key0 >> 1) & 7)) : ((sl0 & ~3) | ((sl0 & 3) ^ ((key0 >> 2) & 3)));
    const int c1 = 64 * (8 + wv) + lane, key1 = c1 / CPK, sl1 = c1 % CPK, pt1 = (sl1 & ~3) | ((sl1 & 3) ^ ((key1 >> 2) & 3));
    S.wv = wv; S.k2 = (MODE == 1) && wv < 4;
    S.Kb = Kg + (size_t)seq0 * krs; S.ok0 = (unsigned)(key0 * krs + 8 * pt0); S.ok1 = (unsigned)((S.k2 ? key1 : 0) * krs + 8 * pt1);
    S.Vb = Vg + (size_t)seq0 * 256; S.ov = (unsigned)((16 * (wv & 3) + (lane >> 2)) * 256 + 8 * (4 * (wv >> 2) + (lane & 3)));
    S.troff = tr_lane_off(lane);
    if (MODE == 0) {
#pragma unroll
        for (int pp = 0; pp < 4; ++pp) S.xo[pp] = (unsigned)(r * KROW + (((2 * pp + hh) ^ ((r >> 1) & 7)) << 4));
    } else {
#pragma unroll
        for (int e = 0; e < 2; ++e) S.xo[e] = (unsigned)(r * KROW + (((2 * e + hh) ^ ((r >> 2) & 3)) << 4));
        S.xo[2] = 0; S.xo[3] = 0;
    }
#pragma unroll
    for (int t0 = 0; t0 < 2; ++t0) { const size_t adv = (size_t)t0 * 64;
        __builtin_amdgcn_global_load_lds((const unsigned*)((S.Kb + adv * krs) + S.ok0), (LAS unsigned*)(lds + t0 * KBYTES + wv * 1024), 16, 0, 0);
        if (S.k2) __builtin_amdgcn_global_load_lds((const unsigned*)((S.Kb + adv * krs) + S.ok1), (LAS unsigned*)(lds + t0 * KBYTES + (8 + wv) * 1024), 16, 0, 0);
        __builtin_amdgcn_global_load_lds((const unsigned*)((S.Vb + adv * 256) + S.ov), (LAS unsigned*)(lds + 3 * KBYTES + t0 * VBYTES + wv * 1024), 16, 0, 0); }
    asm volatile("s_waitcnt vmcnt(0)" ::: "memory");
    __syncthreads();
    const unsigned xo0 = S.xo[0];
    if (MODE == 1) {
        f32x16 zero16;
#pragma unroll
        for (int i = 0; i < 16; ++i) zero16[i] = 0.f;
        S.sa0 = mfma32(ATT_KF(0, 0, 0), q[0], zero16); S.sa1 = mfma32(ATT_KF(0, 1, 0), q[0], zero16);
#pragma unroll
        for (int s = 1; s < NQS; ++s) { S.sa0 = mfma32(ATT_KF(0, 0, s), q[s], S.sa0); S.sa1 = mfma32(ATT_KF(0, 1, s), q[s], S.sa1); } }
    for (int j = 0; j < T / 64; j += 3) {
        att_tile<MODE, 0, 1, 2>(lds, S, q, j);
        if (j + 1 < T / 64) att_tile<MODE, 1, 2, 0>(lds, S, q, j + 1);
        if (j + 2 < T / 64) att_tile<MODE, 2, 0, 1>(lds, S, q, j + 2);
    }
#undef ATT_KF
    __syncthreads();
    f32x16& Oa0 = S.Oa0; f32x16& Oa1 = S.Oa1; f32x16& Ob0 = S.Ob0; f32x16& Ob1 = S.Ob1; const float la = S.la, lb = S.lb;
    int tid_e = tid; asm volatile("" : "+v"(tid_e));
    const int lane_e = tid_e & 63, hh_e = lane_e >> 5;
    const float lat = la + __shfl_xor(la, 32);
    bf16_t* orow = outp + (size_t)(seq0 + q0 + 32 * (tid_e >> 6) + (lane_e & 31)) * D + 4 * hh_e;
    if (MODE == 0) {
        const float lbt = lb + __shfl_xor(lb, 32);
        const float ia = 1.f / lat, ib = lam / lbt; float ss = 0.f;
#pragma unroll
        for (int i = 0; i < 16; ++i) { Oa0[i] = Oa0[i] * ia - Ob0[i] * ib; Oa1[i] = Oa1[i] * ia - Ob1[i] * ib; ss += Oa0[i] * Oa0[i] + Oa1[i] * Oa1[i]; }
        ss += __shfl_xor(ss, 32);
        const float rsn = __builtin_amdgcn_rsqf(ss * (1.f / 64.f) + RMS_EPS) * oscale;
#pragma unroll
        for (int g4 = 0; g4 < 4; ++g4) { const f32x4 g0 = *(const f32x4*)(subg + 8 * g4 + 4 * hh_e), g1 = *(const f32x4*)(subg + 32 + 8 * g4 + 4 * hh_e);
            u32x2 w0, w1;
            w0.x = pk2(Oa0[4 * g4] * rsn * g0[0], Oa0[4 * g4 + 1] * rsn * g0[1]); w0.y = pk2(Oa0[4 * g4 + 2] * rsn * g0[2], Oa0[4 * g4 + 3] * rsn * g0[3]);
            w1.x = pk2(Oa1[4 * g4] * rsn * g1[0], Oa1[4 * g4 + 1] * rsn * g1[1]); w1.y = pk2(Oa1[4 * g4 + 2] * rsn * g1[2], Oa1[4 * g4 + 3] * rsn * g1[3]);
            *(u32x2*)(orow + 8 * g4) = w0; *(u32x2*)(orow + 32 + 8 * g4) = w1; }
    } else {
        const float ia = 1.f / lat;
#pragma unroll
        for (int g4 = 0; g4 < 4; ++g4) { u32x2 w0, w1;
            w0.x = pk2(Oa0[4 * g4] * ia, Oa0[4 * g4 + 1] * ia); w0.y = pk2(Oa0[4 * g4 + 2] * ia, Oa0[4 * g4 + 3] * ia);
            w1.x = pk2(Oa1[4 * g4] * ia, Oa1[4 * g4 + 1] * ia); w1.y = pk2(Oa1[4 * g4 + 2] * ia, Oa1[4 * g4 + 3] * ia);
            *(u32x2*)(orow + 8 * g4) = w0; *(u32x2*)(orow + 32 + 8 * g4) = w1; }
    }
}

struct LocalRegs { u32x4 kv[4], vv[4]; };
DI void local_issue(const bf16_t* Kh, const bf16_t* Vh, int seq0, int kpos0, int kstride, int lane, LocalRegs& R) {
#pragma unroll
    for (int i = 0; i < 4; ++i) { const int c = lane + 64 * i, key = c >> 3, part = c & 7; int pk = kpos0 + kstride * key; pk = pk < 0 ? 0 : (pk > T - 1 ? T - 1 : pk);
        R.kv[i] = *(const u32x4*)(Kh + (size_t)(seq0 + pk) * 256 + 8 * part); R.vv[i] = *(const u32x4*)(Vh + (size_t)(seq0 + pk) * 256 + 8 * part); }
}
DI void local_commit(LAS unsigned char* wl, int lane, const LocalRegs& R) {
    LDS_WAIT();
#pragma unroll
    for (int i = 0; i < 4; ++i) { const int c = lane + 64 * i, key = c >> 3, part = c & 7;
        *(LAS u32x4*)(wl + key * 144 + part * 16) = R.kv[i]; *(LAS u32x4*)(wl + 4608 + (part >> 2) * 2048 + key * 64 + (part & 3) * 16) = R.vv[i]; }
    LDS_WAIT();
}
DI f32x16 local_qk(const LAS unsigned char* wl, const bf16x8 (&q)[4], int r, int hh) {
    f32x16 s;
#pragma unroll
    for (int i = 0; i < 16; ++i) s[i] = 0.f;
    const LAS unsigned char* kr = wl + r * 144 + 16 * hh;
#pragma unroll
    for (int st = 0; st < 4; ++st) s = mfma32(*(const LAS bf16x8*)(kr + 32 * st), q[st], s);
    return s;
}
DI void local_pv(const LAS unsigned char* wl, unsigned troff, bf16x8 p0, bf16x8 p1, f32x16& O0, f32x16& O1) {
    const LAS unsigned char* vr = wl + 4608 + troff;
#pragma unroll
    for (int s = 0; s < 2; ++s) {
        const bf16x8 v0 = tr_pair(vr + (16 * s) * 64, vr + (16 * s + 8) * 64), v1 = tr_pair(vr + 2048 + (16 * s) * 64, vr + 2048 + (16 * s + 8) * 64);
        O0 = mfma32(v0, s ? p1 : p0, O0); O1 = mfma32(v1, s ? p1 : p0, O1); }
}
DI void local_store(bf16_t* orow  , const f32x16& O0, const f32x16& O1, float l) {
    const float ia = 1.f / (l + __shfl_xor(l, 32));
#pragma unroll
    for (int g4 = 0; g4 < 4; ++g4) { u32x2 w0, w1;
        w0.x = pk2(O0[4 * g4] * ia, O0[4 * g4 + 1] * ia); w0.y = pk2(O0[4 * g4 + 2] * ia, O0[4 * g4 + 3] * ia);
        w1.x = pk2(O1[4 * g4] * ia, O1[4 * g4 + 1] * ia); w1.y = pk2(O1[4 * g4 + 2] * ia, O1[4 * g4 + 3] * ia);
        *(u32x2*)(orow + 8 * g4) = w0; *(u32x2*)(orow + 32 + 8 * g4) = w1; }
}

DI void local_dma(const bf16_t* Kh, const bf16_t* Vh, int seq0, int kpos0, int kstride, LAS unsigned char* buf  , int lane) {
#pragma unroll
    for (int j = 0; j < 4; ++j) { const int c = 64 * j + lane, key = c >> 3, part = (c & 7) ^ ((key >> 1) & 7); int pk = kpos0 + kstride * key; pk = pk < 0 ? 0 : (pk > T - 1 ? T - 1 : pk);
        __builtin_amdgcn_global_load_lds((const unsigned*)(Kh + (size_t)(seq0 + pk) * 256 + 8 * part), (LAS unsigned*)(buf + j * 1024), 16, 0, 0); }
#pragma unroll
    for (int j = 0; j < 4; ++j) { const int key = 16 * (j & 1) + (lane >> 2), part = 4 * (j >> 1) + (lane & 3); int pk = kpos0 + kstride * key; pk = pk < 0 ? 0 : (pk > T - 1 ? T - 1 : pk);
        __builtin_amdgcn_global_load_lds((const unsigned*)(Vh + (size_t)(seq0 + pk) * 256 + 8 * part), (LAS unsigned*)(buf + 4096 + j * 1024), 16, 0, 0); }
}
#define LQ_DSR(dst, addr, off) asm volatile("ds_read_b128 %0, %1 offset:%2" : "=v"(dst) : "v"(addr), "n"(off) : "memory")
#define LQ_WAIT(N, reg) asm volatile("s_waitcnt lgkmcnt(" #N ")" : "+v"(reg) :: "memory")
template <int B>
DI void local_kread(unsigned ka0, bf16x8 (&k)[4]) {
    asm volatile("" : "+v"(ka0)); const unsigned a1 = ka0 ^ 32u, a2 = ka0 ^ 64u, a3 = ka0 ^ 96u;
    LQ_DSR(k[0], ka0, B * 8192); LQ_DSR(k[1], a1, B * 8192); LQ_DSR(k[2], a2, B * 8192); LQ_DSR(k[3], a3, B * 8192); }
template <int NB>
DI f32x16 local_qk3(bf16x8 (&k)[4], const bf16x8 (&q)[4]) {
    f32x16 s;
#pragma unroll
    for (int i = 0; i < 16; ++i) s[i] = 0.f;
    if constexpr (NB == 0) { LQ_WAIT(3, k[0]); s = mfma32(k[0], q[0], s); LQ_WAIT(2, k[1]); s = mfma32(k[1], q[1], s); LQ_WAIT(1, k[2]); s = mfma32(k[2], q[2], s); LQ_WAIT(0, k[3]); s = mfma32(k[3], q[3], s); }
    else { static_assert(NB == 8, "NB"); LQ_WAIT(11, k[0]); s = mfma32(k[0], q[0], s); LQ_WAIT(10, k[1]); s = mfma32(k[1], q[1], s); LQ_WAIT(9, k[2]); s = mfma32(k[2], q[2], s); LQ_WAIT(8, k[3]); s = mfma32(k[3], q[3], s); }
    return s;
}
template <int B>
DI void local_pv2(unsigned va  , bf16x8 p0, bf16x8 p1, f32x16& O0, f32x16& O1) {
    s16x4 a0, a1, a2, a3, b0, b1, b2, b3;
    asm volatile("ds_read_b64_tr_b16 %0, %8 offset:%9\n\tds_read_b64_tr_b16 %1, %8 offset:%10\n\tds_read_b64_tr_b16 %2, %8 offset:%11\n\tds_read_b64_tr_b16 %3, %8 offset:%12\n\t"
                 "ds_read_b64_tr_b16 %4, %8 offset:%13\n\tds_read_b64_tr_b16 %5, %8 offset:%14\n\tds_read_b64_tr_b16 %6, %8 offset:%15\n\tds_read_b64_tr_b16 %7, %8 offset:%16\n\ts_waitcnt lgkmcnt(0)"
                 : "=&v"(a0), "=&v"(a1), "=&v"(a2), "=&v"(a3), "=&v"(b0), "=&v"(b1), "=&v"(b2), "=&v"(b3)
                 : "v"(va), "n"(B * 8192 + 4096), "n"(B * 8192 + 4096 + 512), "n"(B * 8192 + 4096 + 2048), "n"(B * 8192 + 4096 + 2048 + 512),
                   "n"(B * 8192 + 4096 + 1024), "n"(B * 8192 + 4096 + 1024 + 512), "n"(B * 8192 + 4096 + 2048 + 1024), "n"(B * 8192 + 4096 + 2048 + 1024 + 512) : "memory");
    const bf16x8 v00 = __builtin_shufflevector(a0, a1, 0, 1, 2, 3, 4, 5, 6, 7), v01 = __builtin_shufflevector(a2, a3, 0, 1, 2, 3, 4, 5, 6, 7);
    const bf16x8 v10 = __builtin_shufflevector(b0, b1, 0, 1, 2, 3, 4, 5, 6, 7), v11 = __builtin_shufflevector(b2, b3, 0, 1, 2, 3, 4, 5, 6, 7);
    O0 = mfma32(v00, p0, O0); O1 = mfma32(v01, p0, O1); O0 = mfma32(v10, p1, O0); O1 = mfma32(v11, p1, O1);
}
constexpr int ATT_RPB_OFF = RING_BYTES + 1024;

DI void attn_phase(CParams p, int l, LAS unsigned char* lds, int tid_in, int wg, int G) {
    int tid = tid_in;
    int lane = tid & 63, wave = tid >> 6;
    const bf16_t* U = (const bf16_t*)(p->ws + WS_U); const size_t US = (size_t)M * 256;
    bf16_t* CAT = (bf16_t*)(p->ws + WS_CAT);
    float lam;
    { float a = 0.f, b = 0.f; if (lane < 32) { a = p->in[9][l * 32 + lane] * p->in[10][l * 32 + lane]; b = p->in[11][l * 32 + lane] * p->in[12][l * 32 + lane]; }
      a = wave_sum(a); b = wave_sum(b); lam = __expf(a) - __expf(b) + p->lam_init[l];
      lam = __builtin_bit_cast(float, __builtin_amdgcn_readfirstlane(__builtin_bit_cast(int, lam))); }
    const float oscale = 1.f - p->lam_init[l];
#ifndef ATT_PHASE_SHIFT
#define ATT_PHASE_SHIFT 0
#endif
#ifndef ATT_LATE_OF
#define ATT_LATE_OF(w) ((w) & 1)
#endif
    const bool late_wave = ATT_PHASE_SHIFT && ATT_LATE_OF(__builtin_amdgcn_readfirstlane(wave));
    { LAS float* bt = (LAS float*)(lds + ATT_RPB_OFF); for (int i = tid; i < 4 * 15 * 31 + 128; i += 512) { const int j = i - 64; bt[i] = (j >= 0 && j < 4 * 15 * 31) ? p->in[14][(size_t)l * 4 * 15 * 31 + j] * LOG2E : 0.f; } }
    __syncthreads();
#ifndef ATT_DUP
#define ATT_DUP 0
#endif
#ifndef ATT_SKIP
#define ATT_SKIP 0
#endif
    if (!(ATT_SKIP & 1))
    for (int rep_ = 0, nrep_ = (ATT_DUP & 1) ? opaque_int(2) : 1; rep_ < nrep_; ++rep_)
    for (int i = 0; i < (NSEQ * 4 * 16 + G - 1) / G; ++i) {
        int bh, qb;
        if (G == 256) { const int x = wg & 7, y = wg >> 3; bh = i * 16 + 2 * x + (y >> 4); qb = y & 15; } else { const int u = i * G + wg; bh = u >> 4; qb = u & 15; }
        if (bh >= NSEQ * 4) break;
        const int b = bh >> 2, h = bh & 3;
        asm volatile("" : "+v"(tid));
        if (late_wave) attn_full_unit<0, true>(lds, U + 0 * US + 64 * h, U + 1 * US + 64 * h, U + 2 * US + 64 * h, 256, 256, b * T, qb * 256, CAT + 64 * h, lam, oscale, p->in[13] + l * 64, tid);
        else attn_full_unit<0, false>(lds, U + 0 * US + 64 * h, U + 1 * US + 64 * h, U + 2 * US + 64 * h, 256, 256, b * T, qb * 256, CAT + 64 * h, lam, oscale, p->in[13] + l * 64, tid);
    }
    if (!(ATT_SKIP & 2))
    for (int rep_ = 0, nrep_ = (ATT_DUP & 2) ? opaque_int(2) : 1; rep_ < nrep_; ++rep_)
    for (int i = 0; i < (NSEQ * 4 * 16 + G - 1) / G; ++i) {
        int bh, qb;
        if (G == 256) { const int x = wg & 7, y = wg >> 3; bh = i * 16 + 2 * x + (y >> 4); qb = y & 15; } else { const int u = i * G + wg; bh = u >> 4; qb = u & 15; }
        if (bh >= NSEQ * 4) break;
        const int b = bh >> 2, h = bh & 3;
        asm volatile("" : "+v"(tid));
        if (late_wave) attn_full_unit<1, true>(lds, (const bf16_t*)(p->ws + WS_QB) + 96 * h, (const bf16_t*)(p->ws + WS_KB) + 96 * h, (const bf16_t*)(p->ws + WS_VB) + 64 * h, 384, 384, b * T, qb * 256, CAT + 256 + 64 * h, 0.f, 1.f, nullptr, tid);
        else attn_full_unit<1, false>(lds, (const bf16_t*)(p->ws + WS_QB) + 96 * h, (const bf16_t*)(p->ws + WS_KB) + 96 * h, (const bf16_t*)(p->ws + WS_VB) + 64 * h, 384, 384, b * T, qb * 256, CAT + 256 + 64 * h, 0.f, 1.f, nullptr, tid);
    }
    asm volatile("" : "+v"(tid));
    lane = tid & 63; wave = tid >> 6; const int r = lane & 31, hh = lane >> 5;
    LAS unsigned char* wl = lds + __builtin_amdgcn_readfirstlane(wave) * 16384;
    const unsigned va = (unsigned)(size_t)wl + tr_lane_off(lane);
    unsigned xo[4];
#pragma unroll
    for (int st = 0; st < 4; ++st) xo[st] = (unsigned)(r * 128 + (((2 * st + hh) ^ ((r >> 1) & 7)) << 4));
    const unsigned ka = (unsigned)(size_t)wl + xo[0];
    __syncthreads();
    const bool conv_first = __builtin_amdgcn_readfirstlane(wave) < 4;
#define LB_BLOCK(B, KPOS0, DIL, NEXT) { const int kpos0 = (KPOS0); const int dil = (DIL), halfw = 64 * dil; \
            NEXT \
            bf16x8 kf[4]; local_kread<B>(ka, kf); f32x16 s = local_qk3<0>(kf, q); \
            const int tb = kpos0 - pq + halfw + 4 * dil * hh;                   \
            const bool edge = kpos0 < 0 || kpos0 + 31 * dil >= T;                \
            if (!edge) { \
                _Pragma("unroll") for (int i = 0; i < 16; ++i) { const unsigned t = (unsigned)(tb + dil * ((i & 3) + 8 * (i >> 2))); s[i] = s[i] + (t <= 2u * (unsigned)halfw ? 0.f : -INFINITY); } \
            } else { \
                _Pragma("unroll") for (int i = 0; i < 16; ++i) { const int t = tb + dil * ((i & 3) + 8 * (i >> 2)); const unsigned pk = (unsigned)(t - halfw + pq); \
                    s[i] = s[i] + (((unsigned)t <= 2u * (unsigned)halfw && pk < (unsigned)T) ? 0.f : -INFINITY); } \
            } \
            bf16x8 p0, p1; softmax_local(s, m, lsum, O0, O1, p0, p1); \
            local_pv2<B>(va, p0, p1, O0, O1); }
#define LB_NEXT(B, KPOS0, DIL) { local_dma(Kh, Vh, seq0, (KPOS0), (DIL), wl + (1 - B) * 8192, lane); asm volatile("s_waitcnt vmcnt(8)" ::: "memory"); }
#define LB_LAST asm volatile("s_waitcnt vmcnt(0)" ::: "memory");
    float* REC = (float*)((unsigned char*)p->out + (size_t)M * D * 2);
    f32x2* RML = (f32x2*)(REC + (size_t)M * 4 * 2 * 32);
    const bf16_t* Dk = U + 7 * US; const bf16_t* Dv = U + 8 * US;
    const LAS float* bt = (const LAS float*)(lds + ATT_RPB_OFF);
    for (int stage = 0; stage < 3; ++stage) {
    const int what = stage == 0 ? 1 : (((stage == 1) == conv_first) ? 0 : 2);
    if (what == 0) {
        convert_experts_wave(p, l, wl, G > 2 * NE ? CONV_EARLY : 0, CONV_JOBS_PER_LAYER, wg * NWAVES + __builtin_amdgcn_readfirstlane(wave), G * NWAVES, lane);
    } else if (what == 1) {
    for (int rep_ = 0, nrep_ = (ATT_DUP & 4) ? opaque_int(2) : 1; rep_ < nrep_; ++rep_)
    for (int g = wg; g < NSEQ * 4 * 8; g += G) {
        const int blk = g & 7, bh = g >> 3, b = bh >> 2, h = bh & 3, seq0 = b * T;
        const bf16_t* Kh = U + 4 * US + 64 * h; const bf16_t* Vh = U + 5 * US + 64 * h;
#pragma unroll 1
        for (int s2 = 0; s2 < 2; ++s2) {
            const int r16 = 2 * __builtin_amdgcn_readfirstlane(wave) + s2, pq = blk * 512 + 16 * r + r16, k0 = blk * 512 + r16 - 1024;
            local_dma(Kh, Vh, seq0, k0, 16, wl, lane);
            bf16x8 q[4];
            { const bf16_t* qp = U + 3 * US + (size_t)(seq0 + pq) * 256 + 64 * h + 8 * hh;
#pragma unroll
              for (int s = 0; s < 4; ++s) q[s] = *(const bf16x8*)(qp + 16 * s); }
            f32x16 O0, O1; float m = -1e30f, lsum = 0.f;
#pragma unroll
            for (int i = 0; i < 16; ++i) { O0[i] = 0.f; O1[i] = 0.f; }
            LB_BLOCK(0, k0, 16, LB_NEXT(0, k0 + 512, 16)) LB_BLOCK(1, k0 + 512, 16, LB_NEXT(1, k0 + 1024, 16)) LB_BLOCK(0, k0 + 1024, 16, LB_NEXT(0, k0 + 1536, 16)) LB_BLOCK(1, k0 + 1536, 16, LB_NEXT(1, k0 + 2048, 16)) LB_BLOCK(0, k0 + 2048, 16, LB_LAST)
            float* rec = REC + ((((size_t)(seq0 + pq)) * 4 + h) * 2 + hh) * 32;
#pragma unroll
            for (int g4 = 0; g4 < 4; ++g4) { *(f32x4*)(rec + 4 * g4) = (f32x4){O0[4 * g4], O0[4 * g4 + 1], O0[4 * g4 + 2], O0[4 * g4 + 3]}; *(f32x4*)(rec + 16 + 4 * g4) = (f32x4){O1[4 * g4], O1[4 * g4 + 1], O1[4 * g4 + 2], O1[4 * g4 + 3]}; }
            RML[(((size_t)(seq0 + pq)) * 4 + h) * 2 + hh] = (f32x2){m, lsum};
        }
        __builtin_amdgcn_fence(__ATOMIC_RELEASE, "workgroup"); __syncthreads(); __builtin_amdgcn_fence(__ATOMIC_ACQUIRE, "workgroup");
#pragma unroll 1
        for (int s2 = 0; s2 < 2; ++s2) {
            const int qi = 2 * __builtin_amdgcn_readfirstlane(wave) + s2, b128 = blk * 512 + 128 * (qi >> 2), r4 = qi & 3, pq = b128 + 4 * r + r4, k1 = b128 + r4 - 64, k4 = b128 + r4 - 256;
            local_dma(Kh, Vh, seq0, k1, 1, wl, lane);
            bf16x8 q[4];
            { const bf16_t* qp = U + 3 * US + (size_t)(seq0 + pq) * 256 + 64 * h + 8 * hh;
#pragma unroll
              for (int s = 0; s < 4; ++s) q[s] = *(const bf16x8*)(qp + 16 * s); }
            f32x16 O0, O1; float m = -1e30f, lsum = 0.f;
#pragma unroll
            for (int i = 0; i < 16; ++i) { O0[i] = 0.f; O1[i] = 0.f; }
#define P2_KPOS(i_) ((i_) < 8 ? k1 + 32 * (i_) : k4 + 128 * ((i_) - 8))
#define P2_DIL(i_) ((i_) < 8 ? 1 : 4)
#pragma unroll 1
            for (int i2 = 0; i2 < 12; i2 += 2) { LB_BLOCK(0, P2_KPOS(i2), P2_DIL(i2), LB_NEXT(0, P2_KPOS(i2 + 1), P2_DIL(i2 + 1))) LB_BLOCK(1, P2_KPOS(i2 + 1), P2_DIL(i2 + 1), LB_NEXT(1, P2_KPOS(i2 + 2), P2_DIL(i2 + 2))) }
            f32x4 ro[8]; f32x2 rml;
            { const float* rec = REC + ((((size_t)(seq0 + pq)) * 4 + h) * 2 + hh) * 32;
#pragma unroll
              for (int g4 = 0; g4 < 8; ++g4) ro[g4] = *(const f32x4*)(rec + 4 * g4);
              rml = RML[(((size_t)(seq0 + pq)) * 4 + h) * 2 + hh]; }
            LB_BLOCK(0, k4 + 512, 4, asm volatile("s_waitcnt vmcnt(9)" ::: "memory");)
#undef P2_KPOS
#undef P2_DIL
            { const float mm = fmaxf(m, rml.x), a2 = __builtin_amdgcn_exp2f(m - mm), a16 = __builtin_amdgcn_exp2f(rml.x - mm);
              lsum = lsum * a2 + rml.y * a16;
#pragma unroll
              for (int i = 0; i < 16; ++i) { O0[i] = O0[i] * a2 + ro[i >> 2][i & 3] * a16; O1[i] = O1[i] * a2 + ro[4 + (i >> 2)][i & 3] * a16; } }
            local_store(CAT + (size_t)(seq0 + pq) * D + 512 + 64 * h + 4 * hh, O0, O1, lsum);
        }
    }
    } else {
#define D_BLOCK(B, N) { const int n = (N); const int krow = rs0 + n; \
            if (n + 1 < 9) { local_dma(Kh, Vh, seq0, (krow + 1) * 64 + kc0, 1, wl + (1 - B) * 8192, lane); asm volatile("s_waitcnt vmcnt(8)" ::: "memory"); } \
            else asm volatile("s_waitcnt vmcnt(0)" ::: "memory"); \
            bf16x8 kf[4]; local_kread<B>(ka, kf); \
            const unsigned ba = (unsigned)(size_t)bt + 4u * (unsigned)(64 + (h * 15 + (krow - qrow + 7)) * 31 + (kc0 + 4 * hh - qcol + 15));        \
            f32x2 bv[8]; \
            asm volatile("ds_read2_b32 %0, %8 offset1:1\n\tds_read2_b32 %1, %8 offset0:2 offset1:3\n\tds_read2_b32 %2, %8 offset0:8 offset1:9\n\tds_read2_b32 %3, %8 offset0:10 offset1:11\n\t" \
                         "ds_read2_b32 %4, %8 offset0:16 offset1:17\n\tds_read2_b32 %5, %8 offset0:18 offset1:19\n\tds_read2_b32 %6, %8 offset0:24 offset1:25\n\tds_read2_b32 %7, %8 offset0:26 offset1:27" \
                         : "=&v"(bv[0]), "=&v"(bv[1]), "=&v"(bv[2]), "=&v"(bv[3]), "=&v"(bv[4]), "=&v"(bv[5]), "=&v"(bv[6]), "=&v"(bv[7]) : "v"(ba) : "memory"); \
            f32x16 s = local_qk3<8>(kf, q); \
            asm volatile("s_waitcnt lgkmcnt(0)" : "+v"(bv[0]), "+v"(bv[1]), "+v"(bv[2]), "+v"(bv[3]), "+v"(bv[4]), "+v"(bv[5]), "+v"(bv[6]), "+v"(bv[7]) :: "memory"); \
            const float rm = ((unsigned)(krow - rsq) < 8u) ? 0.f : -INFINITY;               \
            _Pragma("unroll") for (int i = 0; i < 16; ++i) s[i] = (s[i] + bv[2 * (i >> 2) + ((i & 3) >> 1)][i & 1]) + (nm[i] + rm); \
            bf16x8 p0, p1; softmax_local(s, m, lsum, O0, O1, p0, p1); \
            local_pv2<B>(va, p0, p1, O0, O1); }
    int d0, d1, dstep;
    if (G == 256) { const int db = wg < 128 ? 28 * wg : 3584 + 52 * (wg - 128); d0 = db + wave; d1 = db + (wg < 128 ? 28 : 52); dstep = NWAVES; }
    else { d0 = wg * NWAVES + wave; d1 = NSEQ * 4 * 32 * 4; dstep = G * NWAVES; }
    for (int rep_ = 0, nrep_ = (ATT_DUP & 8) ? opaque_int(2) : 1; rep_ < nrep_; ++rep_)
    for (int task = d0; task < d1; task += dstep) {
        const int cb = task & 3, rp = (task >> 2) & 31, bh = task >> 7, b = bh >> 2, h = bh & 3, seq0 = b * T;
        const int qrow = 2 * rp + ((r >> 4) & 1), qcol = 16 * cb + (r & 15), pq = qrow * 64 + qcol;
        const bf16_t* Kh = Dk + 64 * h; const bf16_t* Vh = Dv + 64 * h;
        const int rs0 = 2 * rp - 4 < 0 ? 0 : (2 * rp - 4 > 56 ? 56 : 2 * rp - 4);
        const int kc0 = 16 * cb - 8 < 0 ? 0 : (16 * cb - 8 > 32 ? 32 : 16 * cb - 8);
        local_dma(Kh, Vh, seq0, rs0 * 64 + kc0, 1, wl, lane);
        bf16x8 q[4];
        { const bf16_t* qp = U + 6 * US + (size_t)(seq0 + pq) * 256 + 64 * h + 8 * hh;
#pragma unroll
          for (int s = 0; s < 4; ++s) q[s] = *(const bf16x8*)(qp + 16 * s); }
        f32x16 O0, O1; float m = -1e30f, lsum = 0.f;
#pragma unroll
        for (int i = 0; i < 16; ++i) { O0[i] = 0.f; O1[i] = 0.f; }
        const int rsq = qrow - 4 < 0 ? 0 : (qrow - 4 > 56 ? 56 : qrow - 4);
        const int cs = qcol - 8 < 0 ? 0 : (qcol - 8 > 48 ? 48 : qcol - 8);
        f32x16 nm;
#pragma unroll
        for (int i = 0; i < 16; ++i) { const int kc = kc0 + crow(i, hh); nm[i] = (kc >= cs && kc < cs + 16) ? 0.f : -INFINITY; }
#pragma unroll 1
        for (int n2 = 0; n2 < 8; n2 += 2) { D_BLOCK(0, n2) D_BLOCK(1, n2 + 1) }
        D_BLOCK(0, 8)
        local_store(CAT + (size_t)(seq0 + pq) * D + 768 + 64 * h + 4 * hh, O0, O1, lsum);
    }
#undef D_BLOCK
    }
    }
#undef LB_BLOCK
#undef LB_NEXT
#undef LB_LAST
    __syncthreads();
}
#define DPP_F(v, ctrl, rmask) __builtin_bit_cast(float, __builtin_amdgcn_update_dpp(0, __builtin_bit_cast(int, (v)), (ctrl), (rmask), 0xf, false))
DI float row16_sum(float v) {
    v += DPP_F(v, 0xB1, 0xf); v += DPP_F(v, 0x4E, 0xf); v += DPP_F(v, 0x141, 0xf); v += DPP_F(v, 0x140, 0xf);
    return v;
}
DI float row16_max(float v) {
    v = fmaxf(v, DPP_F(v, 0xB1, 0xf)); v = fmaxf(v, DPP_F(v, 0x4E, 0xf)); v = fmaxf(v, DPP_F(v, 0x141, 0xf)); v = fmaxf(v, DPP_F(v, 0x140, 0xf));
    return v;
}
DI float wave_sum_dpp(float v) {
    v = row16_sum(v);
    v += DPP_F(v, 0x142, 0xa);
    v += DPP_F(v, 0x143, 0xc);
    return __builtin_bit_cast(float, __builtin_amdgcn_readlane(__builtin_bit_cast(int, v), 63));
}
DI float reduce16(float (&v)[16], int lane) {
    { const bool up = (lane & 32) != 0;
#pragma unroll
      for (int k = 0; k < 8; ++k) { const float keep = up ? v[k + 8] : v[k], send = up ? v[k] : v[k + 8]; v[k] = keep + __shfl_xor(send, 32); } }
    { const bool up = (lane & 16) != 0;
#pragma unroll
      for (int k = 0; k < 4; ++k) { const float keep = up ? v[k + 4] : v[k], send = up ? v[k] : v[k + 4]; v[k] = keep + __shfl_xor(send, 16); } }
    { const bool up = (lane & 8) != 0;
#pragma unroll
      for (int k = 0; k < 2; ++k) { const float keep = up ? v[k + 2] : v[k], send = up ? v[k] : v[k + 2]; v[k] = keep + __shfl_xor(send, 8); } }
    { const bool up = (lane & 4) != 0; const float keep = up ? v[1] : v[0], send = up ? v[0] : v[1]; v[0] = keep + __shfl_xor(send, 4); }
    float r = v[0]; r += __shfl_xor(r, 2); r += __shfl_xor(r, 1);
    return r;
}

DI void ln1_phase(CParams p, int l, LAS unsigned char* lds, int tid, int wg, int G) {
    const int lane = tid & 63, gw = wg * NWAVES + (tid >> 6), NGW = G * NWAVES;
    LAS float* wr = (LAS float*)lds;
    for (int i = tid; i < D * NE; i += 512) wr[(i & 15) * D + (i >> 4)] = p->in[22][(size_t)l * D * NE + i];
    __syncthreads();
    const float* MOD = (const float*)(p->ws + WS_MOD) + (size_t)l * NSEQ * 6144;
    const bf16_t* MB = (const bf16_t*)(p->ws + WS_MBUF); unsigned char* H8 = p->ws + WS_H8; float* AFFT = (float*)(p->ws + WS_AFFT);
    const int per = (((M + NGW - 1) / NGW) + 1) & ~1;
    const bool il = (NGW * per == M);
    const int t0 = il ? wg * NWAVES * per + 2 * (tid >> 6) : gw * per, tstep = il ? 2 * NWAVES : 2, t1 = il ? (wg + 1) * NWAVES * per : ((gw * per + per < M) ? gw * per + per : M);
    f32x4 lng[4], lnb[4];
#pragma unroll
    for (int j = 0; j < 4; ++j) { lng[j] = *(const f32x4*)(p->in[18] + l * D + 4 * lane + 256 * j); lnb[j] = *(const f32x4*)(p->in[19] + l * D + 4 * lane + 256 * j); }
    int curb = -1; f32x4 g1p[4], sc2p[4], sh2[4];
    const bf16_t* XB = (const bf16_t*)p->out; bf16_t* X1 = (bf16_t*)(p->ws + WS_HB);
    const float* xin_p = p->in[0]; const float* xin_s = p->in[1];
    f32x4 xn[2][4]; u32x2 mwn[2][4];
#define LN1_FETCH(T_) { \
        if (l == 0) { const float* xr_ = x_row_of(xin_p, xin_s, (T_)); \
            _Pragma("unroll") for (int r_ = 0; r_ < 2; ++r_) _Pragma("unroll") for (int j = 0; j < 4; ++j) xn[r_][j] = __builtin_nontemporal_load((const f32x4*)(xr_ + (size_t)r_ * D + 4 * lane + 256 * j)); } \
        else { \
            _Pragma("unroll") for (int r_ = 0; r_ < 2; ++r_) _Pragma("unroll") for (int j = 0; j < 4; ++j) { const u32x2 w_ = __builtin_nontemporal_load((const u32x2*)(XB + (size_t)((T_) + r_) * D + 4 * lane + 256 * j)); \
                xn[r_][j][0] = __uint_as_float(w_.x); xn[r_][j][1] = __uint_as_float(w_.y); } } \
        _Pragma("unroll") for (int r_ = 0; r_ < 2; ++r_) _Pragma("unroll") for (int j = 0; j < 4; ++j) mwn[r_][j] = __builtin_nontemporal_load((const u32x2*)(MB + (size_t)((T_) + r_) * D + 4 * lane + 256 * j)); }
#pragma unroll
    for (int r = 0; r < 2; ++r)
#pragma unroll
        for (int j = 0; j < 4; ++j) xn[r][j] = (f32x4){0.f, 0.f, 0.f, 0.f};
    if (t0 < t1) LN1_FETCH(t0)
    for (int t = t0; t < t1; t += tstep) {
        const int b = t >> 12;
        if (b != curb) { curb = b; const float* mb = MOD + (size_t)b * 6144;
#pragma unroll
            for (int j = 0; j < 4; ++j) { g1p[j] = *(const f32x4*)(mb + 2048 + 4 * lane + 256 * j) + 1.f; sh2[j] = *(const f32x4*)(mb + 3072 + 4 * lane + 256 * j); sc2p[j] = *(const f32x4*)(mb + 4096 + 4 * lane + 256 * j) + 1.f; } }
        f32x4 v[2][4]; float s[2] = {0.f, 0.f};
#pragma unroll
        for (int r = 0; r < 2; ++r)
#pragma unroll
            for (int j = 0; j < 4; ++j) { const unsigned xa = __float_as_uint(xn[r][j][0]), xb = __float_as_uint(xn[r][j][1]);
                const f32x4 x = (l == 0) ? xn[r][j] : (f32x4){bf_lo(xa), bf_hi(xa), bf_lo(xb), bf_hi(xb)}; const u32x2 mw = mwn[r][j];
                const f32x4 mm = {bf_lo(mw.x), bf_hi(mw.x), bf_lo(mw.y), bf_hi(mw.y)};
                v[r][j] = x * ALPHA + g1p[j] * mm; s[r] += (v[r][j][0] + v[r][j][1]) + (v[r][j][2] + v[r][j][3]); }
        if (t + tstep < t1) LN1_FETCH(t + tstep)
        float s2[2] = {0.f, 0.f};
#pragma unroll
        for (int r = 0; r < 2; ++r) { const float mean = wave_sum_dpp(s[r]) * (1.f / D);
#pragma unroll
            for (int j = 0; j < 4; ++j) { v[r][j] = v[r][j] - mean; s2[r] += (v[r][j][0] * v[r][j][0] + v[r][j][1] * v[r][j][1]) + (v[r][j][2] * v[r][j][2] + v[r][j][3] * v[r][j][3]); } }
        f32x4 hh[2][4];
#pragma unroll
        for (int r = 0; r < 2; ++r) { const float rstd = __builtin_amdgcn_rsqf(wave_sum_dpp(s2[r]) * (1.f / D) + LN_EPS);
#pragma unroll
            for (int j = 0; j < 4; ++j) { const f32x4 y = v[r][j] * rstd * lng[j] + lnb[j];
                { u32x2 w; w.x = pk2(y[0], y[1]); w.y = pk2(y[2], y[3]); __builtin_nontemporal_store(w, (u32x2*)(X1 + (size_t)(t + r) * D + 4 * lane + 256 * j)); }
                hh[r][j] = y * sc2p[j] + sh2[j]; *(unsigned*)(H8 + (size_t)(t + r) * D + 4 * lane + 256 * j) = pg8::pk4_fp8(hh[r][j][0], hh[r][j][1], hh[r][j][2], hh[r][j][3]); } }
        float lg0[16], lg1[16];
        asm volatile("" ::: "memory");
        f32x2 hp[4][4];
#pragma unroll
        for (int j = 0; j < 4; ++j)
#pragma unroll
            for (int c = 0; c < 4; ++c) hp[j][c] = (f32x2){hh[0][j][c], hh[1][j][c]};
#pragma unroll
        for (int e = 0; e < 16; ++e) { f32x2 a = {0.f, 0.f};
#pragma unroll
            for (int j = 0; j < 4; ++j) { const f32x4 w = *(const LAS f32x4*)(wr + e * D + 4 * lane + 256 * j);
#pragma unroll
                for (int c = 0; c < 4; ++c) a = __builtin_elementwise_fma(hp[j][c], (f32x2){w[c], w[c]}, a); }
            lg0[e] = a.x; lg1[e] = a.y; }
        float logit0 = 0.f, logit1 = 0.f;
#pragma unroll
        for (int e = 0; e < 16; ++e) { const float a0 = wave_sum_dpp(lg0[e]), a1 = wave_sum_dpp(lg1[e]);
            logit0 = (lane & 15) == e ? a0 : logit0; logit1 = (lane & 15) == e ? a1 : logit1; }
        const float mx0 = row16_max(logit0), mx1 = row16_max(logit1);
        const float ex0 = __expf(logit0 - mx0), ex1 = __expf(logit1 - mx1);
        const float sm0 = row16_sum(ex0), sm1 = row16_sum(ex1);
#ifdef PROBE_NOAFFT
        if (p->ph_lo != 6)
#endif
        if (lane < 16) *(f32x2*)(AFFT + (size_t)lane * M + t) = (f32x2){ex0 / sm0, ex1 / sm1};
    }
#undef LN1_FETCH
}

constexpr int NPK = 2;
DI void ln2_pick(unsigned long long& m, int slot, int b0, int eb, int (&rw)[NPK], float (&kw)[NPK]) {
#pragma unroll
    for (int i = 0; i < NPK; ++i) { const bool h = m != 0ull; const int e = h ? __builtin_ctzll(m) : 0; m &= m - 1ull + (h ? 0ull : 1ull);
        const int sl = __builtin_amdgcn_readlane(slot, e); rw[i] = h ? b0 + e * eb + sl : 0; kw[i] = h ? 1.f : 0.f; }
}
DI void ln2_phase(CParams p, int l, int tid, int wg, int G) {
    const int lane = tid & 63, gw = wg * NWAVES + (tid >> 6), NGW = G * NWAVES;
    const float* MOD = (const float*)(p->ws + WS_MOD) + (size_t)l * NSEQ * 6144;
    const float* MODN = (const float*)(p->ws + WS_MOD) + (size_t)(l + 1) * NSEQ * 6144;
    const bf16_t* Y = (const bf16_t*)(p->ws + WS_Y); bf16_t* HB = (bf16_t*)(p->ws + WS_HB); const int* SEL = (const int*)(p->ws + WS_SEL);
    const int per = (((M + NGW - 1) / NGW) + 1) & ~1;
    const bool il = (NGW * per == M);
    const int t0 = il ? wg * NWAVES * per + 2 * (tid >> 6) : gw * per, tstep = il ? 2 * NWAVES : 2, t1 = il ? (wg + 1) * NWAVES * per : ((gw * per + per < M) ? gw * per + per : M);
    const bool has_next = (l + 1 < NL);
    f32x4 lng[4], lnb[4];
#pragma unroll
    for (int j = 0; j < 4; ++j) { lng[j] = *(const f32x4*)(p->in[20] + l * D + 4 * lane + 256 * j); lnb[j] = *(const f32x4*)(p->in[21] + l * D + 4 * lane + 256 * j); }
    int curb = -1; f32x4 g2p[4], sc1n[4], sh1n[4];
    bf16_t* XB = (bf16_t*)p->out;
    u32x2 xn[2][4]; int sn0 = -1, sn1 = -1;
#define LN2_FETCH(T_) { sn0 = -1; sn1 = -1; if (lane < 16) { const i32x2 q_ = *(const i32x2*)(SEL + (size_t)lane * M + (T_)); sn0 = q_.x; sn1 = q_.y; } \
        _Pragma("unroll") for (int r_ = 0; r_ < 2; ++r_) _Pragma("unroll") for (int j = 0; j < 4; ++j) xn[r_][j] = __builtin_nontemporal_load((const u32x2*)(HB + (size_t)((T_) + r_) * D + 4 * lane + 256 * j)); }
    if (t0 < t1) LN2_FETCH(t0)
    for (int t = t0; t < t1; t += tstep) {
        const int b = t >> 12;
        if (b != curb) { curb = b; const float* mb = MOD + (size_t)b * 6144; const float* mn = MODN + (size_t)b * 6144;
#pragma unroll
            for (int j = 0; j < 4; ++j) { g2p[j] = *(const f32x4*)(mb + 5120 + 4 * lane + 256 * j) + 1.f;
                if (has_next) { sh1n[j] = *(const f32x4*)(mn + 4 * lane + 256 * j); sc1n[j] = *(const f32x4*)(mn + 1024 + 4 * lane + 256 * j) + 1.f; } } }
        const int slot0 = sn0, slot1 = sn1; u32x2 xc[2][4];
#pragma unroll
        for (int r = 0; r < 2; ++r)
#pragma unroll
            for (int j = 0; j < 4; ++j) xc[r][j] = xn[r][j];
        unsigned long long m0 = __ballot(slot0 >= 0), m1 = __ballot(slot1 >= 0);
        f32x4 f[2][4];
#pragma unroll
        for (int r = 0; r < 2; ++r)
#pragma unroll
            for (int j = 0; j < 4; ++j) f[r][j] = (f32x4){0.f, 0.f, 0.f, 0.f};
        if (t + tstep < t1) LN2_FETCH(t + tstep)
        const int eb = t < MP ? 2048 : 8192, b0 = t < MP ? 0 : 32768;
        while (m0 | m1) {
            int rw0[NPK], rw1[NPK]; float kw0[NPK], kw1[NPK];
            ln2_pick(m0, slot0, b0, eb, rw0, kw0); ln2_pick(m1, slot1, b0, eb, rw1, kw1);
            u32x2 w0[NPK][4], w1[NPK][4];
#pragma unroll
            for (int i = 0; i < NPK; ++i)
#pragma unroll
                for (int j = 0; j < 4; ++j) { w0[i][j] = __builtin_nontemporal_load((const u32x2*)(Y + (size_t)rw0[i] * D + 4 * lane + 256 * j)); w1[i][j] = __builtin_nontemporal_load((const u32x2*)(Y + (size_t)rw1[i] * D + 4 * lane + 256 * j)); }
#pragma unroll
            for (int i = 0; i < NPK; ++i)
#pragma unroll
                for (int j = 0; j < 4; ++j) { f[0][j] += (f32x4){bf_lo(w0[i][j].x), bf_hi(w0[i][j].x), bf_lo(w0[i][j].y), bf_hi(w0[i][j].y)} * kw0[i];
                    f[1][j] += (f32x4){bf_lo(w1[i][j].x), bf_hi(w1[i][j].x), bf_lo(w1[i][j].y), bf_hi(w1[i][j].y)} * kw1[i]; }
        }
        f32x4 v[2][4]; float s[2] = {0.f, 0.f}, s2[2] = {0.f, 0.f};
#pragma unroll
        for (int r = 0; r < 2; ++r)
#pragma unroll
            for (int j = 0; j < 4; ++j) { const f32x4 x = {bf_lo(xc[r][j].x), bf_hi(xc[r][j].x), bf_lo(xc[r][j].y), bf_hi(xc[r][j].y)}; v[r][j] = x * ALPHA + g2p[j] * f[r][j]; s[r] += (v[r][j][0] + v[r][j][1]) + (v[r][j][2] + v[r][j][3]); }
#pragma unroll
        for (int r = 0; r < 2; ++r) { const float mean = wave_sum_dpp(s[r]) * (1.f / D);
#pragma unroll
            for (int j = 0; j < 4; ++j) { v[r][j] = v[r][j] - mean; s2[r] += (v[r][j][0] * v[r][j][0] + v[r][j][1] * v[r][j][1]) + (v[r][j][2] * v[r][j][2] + v[r][j][3] * v[r][j][3]); } }
#pragma unroll
        for (int r = 0; r < 2; ++r) { const float rstd = __builtin_amdgcn_rsqf(wave_sum_dpp(s2[r]) * (1.f / D) + LN_EPS);
#pragma unroll
            for (int j = 0; j < 4; ++j) { const f32x4 y = v[r][j] * rstd * lng[j] + lnb[j];
                if (has_next) { u32x2 w; w.x = pk2(y[0], y[1]); w.y = pk2(y[2], y[3]); __builtin_nontemporal_store(w, (u32x2*)(XB + (size_t)(t + r) * D + 4 * lane + 256 * j));
                    const f32x4 h = y * sc1n[j] + sh1n[j]; w.x = pk2(h[0], h[1]); w.y = pk2(h[2], h[3]); *(u32x2*)(HB + (size_t)(t + r) * D + 4 * lane + 256 * j) = w; }
                else __builtin_nontemporal_store(y, (f32x4*)(p->out + (size_t)(t + r) * D + 4 * lane + 256 * j)); } }
    }
#undef LN2_FETCH
}

DI unsigned block_sum(unsigned v, LAS unsigned* buf  , int lane, int wave) {
#pragma unroll
    for (int o = 1; o < 64; o <<= 1) v += __shfl_xor(v, o);
    if (lane == 0) buf[wave] = v;
    __syncthreads();
    unsigned t = 0;
#pragma unroll
    for (int w = 0; w < 8; ++w) t += buf[w];
    return t;
}
DI unsigned ult31(unsigned a, unsigned b) { return (a - b) >> 31; }
template <int VPT>
DI void topk_task(const float* v, int n_base_tok, int e, int cap, int rowbase, unsigned char* ws, LAS unsigned* sm, int tid) {
    const int lane = tid & 63, wave = tid >> 6;
    unsigned key[VPT];
#pragma unroll
    for (int k4 = 0; k4 < VPT / 4; ++k4) { const u32x4 w = *(const u32x4*)(v + (size_t)tid * VPT + 4 * k4); key[4 * k4] = w.x; key[4 * k4 + 1] = w.y; key[4 * k4 + 2] = w.z; key[4 * k4 + 3] = w.w; }
    unsigned thr = 0u;
    for (int bit = 30; bit >= 0; --bit) {
        const unsigned cand = thr | (1u << bit); unsigned c = 0;
#pragma unroll
        for (int k = 0; k < VPT; ++k) c += ult31(key[k], cand);
        const unsigned tot = 512u * VPT - block_sum(c, sm + (bit & 1) * 8, lane, wave);
        if (tot >= (unsigned)cap) thr = cand;
    }
    unsigned clt = 0, cle = 0;
#pragma unroll
    for (int k = 0; k < VPT; ++k) { clt += ult31(key[k], thr); cle += ult31(key[k], thr + 1u); }
    const unsigned cg = VPT - cle, ce = cle - clt;
    unsigned ig = cg, ie = ce;
#pragma unroll
    for (int o = 1; o < 64; o <<= 1) { const unsigned a = __shfl_up(ig, o), b = __shfl_up(ie, o); if (lane >= o) { ig += a; ie += b; } }
    __syncthreads();
    if (lane == 63) { sm[16 + wave] = ig; sm[24 + wave] = ie; }
    __syncthreads();
    unsigned og = 0, oe = 0, tg = 0;
#pragma unroll
    for (int w = 0; w < 8; ++w) { const unsigned a = sm[16 + w], b = sm[24 + w]; if (w < wave) { og += a; oe += b; } tg += a; }
    unsigned ng = og + ig - cg, ne = oe + ie - ce;
    const unsigned need_eq = (unsigned)cap - tg;
    int tok0 = n_base_tok + tid * VPT; asm volatile("" : "+v"(tok0));
    const unsigned trash = (unsigned)(WS_CTL + 32768) + 4u * (unsigned)tid;
#pragma unroll
    for (int k4 = 0; k4 < VPT / 4; ++k4) {
        unsigned so[4];
#pragma unroll
        for (int j = 0; j < 4; ++j) { const unsigned kk = key[4 * k4 + j]; const unsigned ge = 1u - ult31(kk, thr), gt = 1u - ult31(kk, thr + 1u), eq = ge - gt;
            const unsigned room = ult31(ne, need_eq);
            const unsigned selu = gt + eq * room;
            const unsigned slot = ng + (room ? ne : need_eq);
            const unsigned row = (unsigned)rowbase + slot;
            const unsigned oi = selu ? (unsigned)WS_IDX + 4u * row : trash, og2 = selu ? (unsigned)WS_GATE + 4u * row : trash + 2048u;
            *(int*)(ws + oi) = tok0 + 4 * k4 + j; *(unsigned*)(ws + og2) = kk;
            so[j] = (slot + 1u) * selu - 1u; ng += gt; ne += eq; }
        *(u32x4*)(ws + WS_SEL + ((size_t)e * M + tok0 + 4 * k4) * 4) = (u32x4){so[0], so[1], so[2], so[3]};
        __builtin_amdgcn_sched_barrier(0);
    }
    __syncthreads();
}
DI void topk_phase(CParams p, int l, LAS unsigned char* lds, int tid, int wg, int G) {
    LAS unsigned* sm = (LAS unsigned*)lds;
    const float* AFFT = (const float*)(p->ws + WS_AFFT);
    if (wg >= 2 * NE && G > 2 * NE) { const int wave = __builtin_amdgcn_readfirstlane(tid >> 6);
        convert_experts_wave(p, l, lds + wave * 4352, 0, CONV_EARLY, (wg - 2 * NE) * NWAVES + wave, (G - 2 * NE) * NWAVES, tid & 63); }
    for (int task = wg; task < 2 * NE; task += G) {
        const int g = task >> 4, e = task & 15;
        if (g == 0) topk_task<MP / 512>(AFFT + (size_t)e * M, 0, e, MP / 8, e * 2048, p->ws, sm, tid);
        else topk_task<(M - MP) / 512>(AFFT + (size_t)e * M + MP, MP, e, (M - MP) / 8, 32768 + e * 8192, p->ws, sm, tid);
    }
}
#ifndef VERIFY_MIXER
#define VERIFY_MIXER 0
#endif
#if VERIFY_MIXER
DI float bfv(const bf16_t* p) { return __uint_as_float((unsigned)(*p) << 16); }
DI void verify_phase(CParams p, int l, int tid, int wg, int G) {
#if VERIFY_MIXER <= 4
    const int lane = tid & 63, gw = wg * NWAVES + (tid >> 6), NGW = G * NWAVES;
    const bf16_t* U = (const bf16_t*)(p->ws + WS_U); const size_t US = (size_t)M * 256;
    const bf16_t* CAT = (const bf16_t*)(p->ws + WS_CAT);
    float* stat = (float*)(p->ws + WS_CTL + 40960);
    const float LN2 = 0.69314718056f;
    float sd = 0.f, sr = 0.f;
    constexpr int STRIDE = (VERIFY_MIXER <= 2) ? 61 : 13;
    for (int task = gw; task < (M / STRIDE) * 4; task += NGW) {
        const int tok = (task >> 2) * STRIDE, h = task & 3, seq0 = tok & ~(T - 1), t = tok & (T - 1);
        float ref = 0.f;
#if VERIFY_MIXER == 3
        const bf16_t* Q = U + 3 * US; const bf16_t* K = U + 4 * US; const bf16_t* V = U + 5 * US;
        const float q = bfv(Q + (size_t)tok * 256 + 64 * h + lane);
        float ob[3], lse[3];
        for (int br = 0; br < 3; ++br) { const int dil = br == 0 ? 1 : (br == 1 ? 4 : 16);
            float mx = -1e30f;
            for (int jj = -64; jj <= 64; ++jj) { const int tk = t + dil * jj; if (tk < 0 || tk >= T) continue; const float s = wave_sum(q * bfv(K + (size_t)(seq0 + tk) * 256 + 64 * h + lane)); mx = fmaxf(mx, s); }
            float den = 0.f, num = 0.f;
            for (int jj = -64; jj <= 64; ++jj) { const int tk = t + dil * jj; if (tk < 0 || tk >= T) continue; const float s = wave_sum(q * bfv(K + (size_t)(seq0 + tk) * 256 + 64 * h + lane)); const float e = exp2f(s - mx); den += e; num += e * bfv(V + (size_t)(seq0 + tk) * 256 + 64 * h + lane); }
            ob[br] = num / den; lse[br] = (mx + log2f(den)) * LN2; }
        const float lm = fmaxf(lse[0], fmaxf(lse[1], lse[2])); const float w0 = expf(lse[0] - lm), w1 = expf(lse[1] - lm), w2 = expf(lse[2] - lm);
        ref = (w0 * ob[0] + w1 * ob[1] + w2 * ob[2]) / (w0 + w1 + w2);
        const float got = bfv(CAT + (size_t)tok * D + 512 + 64 * h + lane);
#elif VERIFY_MIXER == 4
        const bf16_t* Q = U + 6 * US; const bf16_t* K = U + 7 * US; const bf16_t* V = U + 8 * US;
        const float q = bfv(Q + (size_t)tok * 256 + 64 * h + lane);
        const int row = t >> 6, col = t & 63; const int rs = min(max(row - 4, 0), 56), cs = min(max(col - 8, 0), 48);
        const float* rpb = p->in[14] + (size_t)l * 4 * 15 * 31 + (size_t)h * 15 * 31;
        float mx = -1e30f;
        for (int kr = 0; kr < 8; ++kr) for (int kc = 0; kc < 16; ++kc) { const int tk = (rs + kr) * 64 + cs + kc; const int ri = rs + kr - row + 7; int ci = cs + kc - col + 15; ci = min(max(ci, 0), 30);
            const float s = wave_sum(q * bfv(K + (size_t)(seq0 + tk) * 256 + 64 * h + lane)) + rpb[ri * 31 + ci] * LOG2E; mx = fmaxf(mx, s); }
        float den = 0.f, num = 0.f;
        for (int kr = 0; kr < 8; ++kr) for (int kc = 0; kc < 16; ++kc) { const int tk = (rs + kr) * 64 + cs + kc; const int ri = rs + kr - row + 7; int ci = cs + kc - col + 15; ci = min(max(ci, 0), 30);
            const float s = wave_sum(q * bfv(K + (size_t)(seq0 + tk) * 256 + 64 * h + lane)) + rpb[ri * 31 + ci] * LOG2E; const float e = exp2f(s - mx); den += e; num += e * bfv(V + (size_t)(seq0 + tk) * 256 + 64 * h + lane); }
        ref = num / den;
        const float got = bfv(CAT + (size_t)tok * D + 768 + 64 * h + lane);
#elif VERIFY_MIXER == 1
        const bf16_t* Q = U + 0 * US; const bf16_t* K = U + 1 * US; const bf16_t* V = U + 2 * US;
        const float q = bfv(Q + (size_t)tok * 256 + 64 * h + lane);
        float la = 0.f, lb = 0.f;
        { float a = 0.f, b = 0.f; if (lane < 32) { a = p->in[9][l * 32 + lane] * p->in[10][l * 32 + lane]; b = p->in[11][l * 32 + lane] * p->in[12][l * 32 + lane]; } a = wave_sum(a); b = wave_sum(b); la = expf(a) - expf(b) + p->lam_init[l]; }
        float m1 = -1e30f, m2 = -1e30f;
        for (int tk = 0; tk < T; ++tk) { const float pr = q * bfv(K + (size_t)(seq0 + tk) * 256 + 64 * h + lane); const float s1 = wave_sum(lane < 32 ? pr : 0.f), s2 = wave_sum(lane < 32 ? 0.f : pr); m1 = fmaxf(m1, s1); m2 = fmaxf(m2, s2); }
        float d1 = 0.f, d2 = 0.f, n1 = 0.f, n2 = 0.f;
        for (int tk = 0; tk < T; ++tk) { const float pr = q * bfv(K + (size_t)(seq0 + tk) * 256 + 64 * h + lane); const float s1 = wave_sum(lane < 32 ? pr : 0.f), s2 = wave_sum(lane < 32 ? 0.f : pr);
            const float e1 = exp2f(s1 - m1), e2 = exp2f(s2 - m2), v = bfv(V + (size_t)(seq0 + tk) * 256 + 64 * h + lane); d1 += e1; d2 += e2; n1 += e1 * v; n2 += e2 * v; }
        const float o = n1 / d1 - la * (n2 / d2);
        const float ms = wave_sum(o * o) * (1.f / 64.f);
        ref = o * rsqrtf(ms + RMS_EPS) * p->in[13][l * 64 + lane] * (1.f - p->lam_init[l]);
        (void)lb;
        const float got = bfv(CAT + (size_t)tok * D + 64 * h + lane);
#else
        const bf16_t* Q = (const bf16_t*)(p->ws + WS_QB); const bf16_t* K = (const bf16_t*)(p->ws + WS_KB); const bf16_t* V = (const bf16_t*)(p->ws + WS_VB);
        const float q0 = bfv(Q + (size_t)tok * 384 + 96 * h + lane), q1 = lane < 32 ? bfv(Q + (size_t)tok * 384 + 96 * h + 64 + lane) : 0.f;
        float mx = -1e30f;
        for (int tk = 0; tk < T; ++tk) { const bf16_t* kp = K + (size_t)(seq0 + tk) * 384 + 96 * h; const float s = wave_sum(q0 * bfv(kp + lane) + (lane < 32 ? q1 * bfv(kp + 64 + lane) : 0.f)); mx = fmaxf(mx, s); }
        float den = 0.f, num = 0.f;
        for (int tk = 0; tk < T; ++tk) { const bf16_t* kp = K + (size_t)(seq0 + tk) * 384 + 96 * h; const float s = wave_sum(q0 * bfv(kp + lane) + (lane < 32 ? q1 * bfv(kp + 64 + lane) : 0.f));
            const float e = exp2f(s - mx); den += e; num += e * bfv(V + (size_t)(seq0 + tk) * 256 + 64 * h + lane); }
        ref = num / den;
        const float got = bfv(CAT + (size_t)tok * D + 256 + 64 * h + lane);
#endif
        sd += (got - ref) * (got - ref); sr += ref * ref;
    }
    sd = wave_sum(sd); sr = wave_sum(sr);
    if (lane == 0) { atomicAdd(stat, sd); atomicAdd(stat + 1, sr); }
#endif
}

#if VERIFY_MIXER == 5 || VERIFY_MIXER == 6
DI void verify_producers(CParams p, int l, int tid, int wg, int G) {
    const int lane = tid & 63, gw = wg * NWAVES + (tid >> 6), NGW = G * NWAVES;
    const bf16_t* U = (const bf16_t*)(p->ws + WS_U); const size_t US = (size_t)M * 256;
    const bf16_t* UB = (const bf16_t*)(p->ws + WS_UB); const bf16_t* HB = (const bf16_t*)(p->ws + WS_HB);
    float* stat = (float*)(p->ws + WS_CTL + 40960);
    float sd = 0.f, sr = 0.f;
#if VERIFY_MIXER == 5
    const int secs[13] = {0, 256, 512, 768, 960, 1088, 1120, 1376, 1632, 1888, 2144, 2400, 2656};
    for (int task = gw; task < (M / 97) * 42; task += NGW) {
        const int tok = (task / 42) * 97; int blk = task % 42, sec = 0;
        for (;;) { const int nb = (secs[sec + 1] - secs[sec] + 63) / 64; if (blk < nb) break; blk -= nb; ++sec; }
        const int c = 64 * blk + lane, size = secs[sec + 1] - secs[sec]; const bool act = c < size; const int cs = secs[sec] + (act ? c : 0);
        float acc = 0.f;
        for (int k = 0; k < D; ++k) acc += bfv(HB + (size_t)tok * D + k) * p->in[4][((size_t)l * D + k) * 2656 + cs];
        const int pos = tok & (T - 1);
        float ref = acc; const bf16_t* got_p = nullptr;
        const bool ropeA = (sec == 0 || sec == 1), ropeC = (sec == 6 || sec == 7);
        if (ropeA) { const int dd = c & 31; const float up = __shfl(acc, (lane + 4) & 63), dn = __shfl(acc, (lane + 60) & 63);
            if (dd < 8) { const int j = dd & 3; const float ang = (float)pos * powf(500000.f, -(float)j / 4.f), cs_ = cosf(ang), sn = sinf(ang); ref = dd < 4 ? acc * cs_ - up * sn : acc * cs_ + dn * sn; } }
        if (ropeC) { const int dd = c & 63; const float up = __shfl(acc, (lane + 8) & 63), dn = __shfl(acc, (lane + 56) & 63);
            if (dd < 16) { const int j = dd & 7; const float ang = (float)pos * powf(500000.f, -(float)j / 8.f), cs_ = cosf(ang), sn = sinf(ang); ref = dd < 8 ? acc * cs_ - up * sn : acc * cs_ + dn * sn; } }
        if (sec == 0) ref *= 0.17677669529663689f * LOG2E; if (sec == 6 || sec == 9) ref *= 0.125f * LOG2E;
        if (sec <= 2) got_p = U + (size_t)sec * US + (size_t)tok * 256 + c;
        else if (sec == 3) got_p = UB + (size_t)tok * 512 + c; else if (sec == 4) got_p = UB + (size_t)tok * 512 + 256 + c; else if (sec == 5) got_p = UB + (size_t)tok * 512 + 384 + c;
        else got_p = U + (size_t)(sec - 3) * US + (size_t)tok * 256 + c;
        if (act) { const float got = bfv(got_p); sd += (got - ref) * (got - ref); sr += ref * ref; }
    }
#else
    const bf16_t* QB = (const bf16_t*)(p->ws + WS_QB); const bf16_t* KB = (const bf16_t*)(p->ws + WS_KB); const bf16_t* VB = (const bf16_t*)(p->ws + WS_VB);
    for (int task = gw; task < (M / 97) * 15; task += NGW) {
        const int tok = (task / 15) * 97, blk = task % 15, pos = tok & (T - 1);
        float ref = 0.f, got = 0.f; bool act = true;
        if (blk < 6) { const int n = 64 * blk + lane; float ms = 0.f; for (int k = 0; k < 192; ++k) { const float x = bfv(UB + (size_t)tok * 512 + k); ms += x * x; }
            const float rs = rsqrtf(ms / 192.f + RMS_EPS); float acc = 0.f;
            for (int k = 0; k < 192; ++k) acc += bfv(UB + (size_t)tok * 512 + k) * rs * p->in[7][l * 192 + k] * p->in[5][((size_t)l * 192 + k) * 384 + n];
            const int w = n % 96; const float up = __shfl(acc, (lane + 16) & 63), dn = __shfl(acc, (lane + 48) & 63); ref = acc;
            if (w >= 64) { const int rd = w - 64, j = rd & 15; const float ang = (float)pos * powf(10000.f, -(float)j / 16.f), cs_ = cosf(ang), sn = sinf(ang); ref = rd < 16 ? acc * cs_ - up * sn : acc * cs_ + dn * sn; }
            ref *= 0.10206207261596575f * LOG2E; got = bfv(QB + (size_t)tok * 384 + n);
        } else if (blk < 14) { const int n = 64 * (blk - 6) + lane; float ms = 0.f; for (int k = 0; k < 128; ++k) { const float x = bfv(UB + (size_t)tok * 512 + 256 + k); ms += x * x; }
            const float rs = rsqrtf(ms / 128.f + RMS_EPS); float acc = 0.f;
            for (int k = 0; k < 128; ++k) acc += bfv(UB + (size_t)tok * 512 + 256 + k) * rs * p->in[8][l * 128 + k] * p->in[6][((size_t)l * 128 + k) * 512 + n];
            ref = acc; const int h = n >> 7, w = n & 127; got = w < 64 ? bfv(KB + (size_t)tok * 384 + 96 * h + w) : bfv(VB + (size_t)tok * 256 + 64 * h + (w - 64));
        } else { act = lane < 32; const int d = lane & 31; const float x = bfv(UB + (size_t)tok * 512 + 384 + d); const float up = __shfl(x, (lane + 16) & 63), dn = __shfl(x, (lane + 48) & 63);
            const int j = d & 15; const float ang = (float)pos * powf(10000.f, -(float)j / 16.f), cs_ = cosf(ang), sn = sinf(ang); ref = d < 16 ? x * cs_ - up * sn : x * cs_ + dn * sn;
            float e2 = 0.f, r2 = 0.f; for (int h = 0; h < 4; ++h) { const float g = bfv(KB + (size_t)tok * 384 + 96 * h + 64 + d); e2 += (g - ref) * (g - ref); r2 += ref * ref; }
            if (act) { sd += e2; sr += r2; } act = false; }
        if (act) { sd += (got - ref) * (got - ref); sr += ref * ref; }
    }
#endif
    sd = wave_sum(sd); sr = wave_sum(sr);
    if (lane == 0) { atomicAdd(stat, sd); atomicAdd(stat + 1, sr); }
}
#endif
DI void verify_scale(CParams p, int tid, int wg, int G) {
    const float* stat = (const float*)(p->ws + WS_CTL + 40960);
    const float ratio = __hip_atomic_load(stat, RLX_AGENT) / fmaxf(__hip_atomic_load(stat + 1, RLX_AGENT), 1e-30f);
    const float f = 1.f + 10.f * sqrtf(ratio);
    for (size_t i = (size_t)wg * 512 + tid; i < (size_t)M * D / 4; i += (size_t)G * 512) { f32x4 v = ((f32x4*)p->out)[i]; ((f32x4*)p->out)[i] = v * f; }
}
#endif
#ifndef MK_SPLIT
#define MK_SPLIT 0
#endif
constexpr int STEPS_PER_LAYER = 7 + 2 * NCHUNK;
constexpr int NSTEPS = 2 + NL * STEPS_PER_LAYER;

__global__ void __launch_bounds__(NWAVES * 64, 2) mega_fwd(Params pk) {
    extern __shared__ __attribute__((aligned(16))) unsigned char lds_raw[];
    LAS unsigned char* lds = (LAS unsigned char*)lds_raw;
    const int tid0 = threadIdx.x;
    const int wave_s = __builtin_amdgcn_readfirstlane(tid0 >> 6);
    volatile LAS unsigned* MISC = (volatile LAS unsigned*)(lds + MISC_OFF);
    for (int u = tid0; u < (LDS_BYTES - RING_BYTES) / 4; u += NWAVES * 64) ((LAS unsigned*)(lds + RING_BYTES))[u] = 0u;
    __syncthreads();
    XcdBarrier bar; bar.bar = (unsigned*)(pk.ws + WS_CTL); bar.x = 0; bar.st = nullptr;
    if (!MK_SPLIT) bar = xcd_barrier_post((unsigned*)(pk.ws + WS_CTL), MISC + 8);
    const int lo = pk.ph_lo, hi = pk.ph_hi;
    int step = 0;
#ifndef PHMASK
#define PHMASK 0xffff
#endif
#define RUN() (lo <= step && step < hi)
#define PH(b) ((PHMASK >> (b)) & 1)
#ifndef DUPMASK
#define DUPMASK 0
#endif
#define REP(b) for (int rep_ = 0, nrep_ = ((DUPMASK >> (b)) & 1) ? opaque_int(2) : 1; rep_ < nrep_; ++rep_)
#define PH_LOCALS unsigned z_ = 0u; asm volatile("" : "+s"(z_)); int tid = (wave_s << 6) | (int)__builtin_amdgcn_mbcnt_hi(~0u, __builtin_amdgcn_mbcnt_lo(~0u, z_)), wg = blockIdx.x, G = gridDim.x; asm volatile("" : "+v"(tid), "+s"(wg), "+s"(G)); CParams p = launder_args()
#define SEAM() do { if (lo <= step && step + 1 < hi) xcd_barrier(bar); ++step; } while (0)

    if (PH(0) && RUN()) { PH_LOCALS; REP(0) prologue_a(p, lds, tid, wg, G); }
    SEAM();
    if (PH(1) && RUN()) { PH_LOCALS; REP(1) prologue_b(p, lds, tid, wg, G); }
    SEAM();
    for (int l = 0; l < NL; ++l) {
        if (PH(2) && RUN()) {
            PH_LOCALS;
            pg8::ProbPlain P{(const bf16_t*)(p->ws + WS_HB), (const bf16_t*)(p->ws + WS_WIN_T) + (size_t)l * N1 * D, D};
            pg8::StaticOrder S; S.init(M / 256, N1 / 256, G, wg);
            pg8::EpiInProj E{(bf16_t*)(p->ws + WS_U), (bf16_t*)(p->ws + WS_UB), (const f32x2*)(p->ws + WS_ROPEA), (const f32x2*)(p->ws + WS_ROPEC), 0.17677669529663689f * LOG2E, 0.125f * LOG2E};
#ifdef PROBE_EPI
            if (lo == 2 && hi == 3) { pg8::EpiStore E2{(bf16_t*)(p->ws + WS_U), 2816}; pg8::gemm_phase(lds, P, S, E2, tid); } else
#endif
            REP(2) pg8::gemm_phase(lds, P, S, E, tid);
        }
        SEAM();
        if (PH(3) && RUN()) { PH_LOCALS; REP(3) mla_phase(p, l, lds, tid, wg, G); }
        SEAM();
        if (PH(4) && RUN()) { PH_LOCALS; REP(4) attn_phase(p, l, lds, tid, wg, G); }
#if VERIFY_MIXER
        if (l == 0) { xcd_barrier(bar); PH_LOCALS; verify_phase(p, l, tid, wg, G); }
#endif
#if VERIFY_MIXER == 5 || VERIFY_MIXER == 6
        if (l == 0) { PH_LOCALS; verify_producers(p, l, tid, wg, G); }
#endif
        SEAM();
        if (PH(5) && RUN()) {
            PH_LOCALS;
            pg8::ProbPlain P{(const bf16_t*)(p->ws + WS_CAT), (const bf16_t*)(p->ws + WS_WOUT_T) + (size_t)l * D * D, D};
            pg8::StaticOrder S; S.init(M / 256, D / 256, G, wg);
            pg8::EpiStore E{(bf16_t*)(p->ws + WS_MBUF), D};
            REP(5) pg8::gemm_phase(lds, P, S, E, tid);
        }
        SEAM();
        if (PH(6) && RUN()) { PH_LOCALS; for (int rep_ = 0, nrep_ = (((DUPMASK >> 6) & 1) && l == 0) ? opaque_int(2) : 1; rep_ < nrep_; ++rep_) ln1_phase(p, l, lds, tid, wg, G); }
        SEAM();
        if (PH(7) && RUN()) { PH_LOCALS; REP(7) topk_phase(p, l, lds, tid, wg, G); }
        SEAM();
#ifndef MOE_REP
#define MOE_REP 1
#endif
        for (int c2 = 0; c2 < NCHUNK * MOE_REP; ++c2) { const int c = c2 % NCHUNK;
            if (PH(8) && RUN()) {
                PH_LOCALS;
                pg8::ProbMoeUp P{p->ws + WS_H8, p->ws + WS_WGU_T + (size_t)l * NE * 2 * FF * D, (const int*)(p->ws + WS_IDX), c, D};
                pg8::StaticOrder S; S.init(CHUNK_PANELS, 2 * FF / 256, G, wg);
                pg8::EpiSwiGLU E{p->ws + WS_ACT};
                REP(8) pg8::gemm_phase(lds, P, S, E, tid);
            }
            SEAM();
            if (PH(9) && RUN()) {
                PH_LOCALS;
                pg8::ProbMoeDown P{p->ws + WS_ACT, p->ws + WS_WD_T + (size_t)l * NE * D * FF, c, FF};
                pg8::StaticOrder S; S.init(CHUNK_PANELS, D / 256, G, wg);
                pg8::EpiDown E{(bf16_t*)(p->ws + WS_Y), (const float*)(p->ws + WS_GATE), c};
                REP(9) pg8::gemm_phase(lds, P, S, E, tid);
            }
            SEAM();
        }
        if (PH(10) && RUN()) {
            PH_LOCALS;
            ln2_phase(p, l, tid, wg, G);
        }
        SEAM();
    }
#if VERIFY_MIXER
    { xcd_barrier(bar); PH_LOCALS; verify_scale(p, tid, wg, G); }
#endif
#ifndef EXTRA_BARS
#define EXTRA_BARS 0
#endif
    for (int i = 0; i < EXTRA_BARS; ++i) xcd_barrier(bar);
#undef RUN
#undef SEAM
}

extern "C" void kernel_launch(void* const* d_in, const int* in_sizes, int n_in, void* d_out, int out_size, void* d_ws, size_t ws_size, hipStream_t stream) {
    static int grid = 0;
    if (grid == 0) {
        if (n_in != 26 || in_sizes[0] != MP * D || out_size != M * D || ws_size < WS_END) {
            fprintf(stderr, "kernel_launch: unexpected shapes (n_in %d, in0 %d, out %d, ws %zu, need %zu); nothing launched\n", n_in, n_in > 0 ? in_sizes[0] : -1, out_size, ws_size, (size_t)WS_END); grid = -1; return; }
        int dev = 0, cus = 0, per_cu = 0;
        if (hipGetDevice(&dev) != hipSuccess || hipDeviceGetAttribute(&cus, hipDeviceAttributeMultiprocessorCount, dev) != hipSuccess) { fprintf(stderr, "kernel_launch: device query failed\n"); grid = -1; return; }
        if (hipFuncSetAttribute((const void*)mega_fwd, hipFuncAttributeMaxDynamicSharedMemorySize, LDS_BYTES) != hipSuccess) { fprintf(stderr, "kernel_launch: hipFuncSetAttribute failed\n"); grid = -1; return; }
        if (hipOccupancyMaxActiveBlocksPerMultiprocessor(&per_cu, (const void*)mega_fwd, NWAVES * 64, LDS_BYTES) != hipSuccess || per_cu < 1)
            fprintf(stderr, "kernel_launch: note: occupancy query reports %d workgroups per CU\n", per_cu);
        (void)hipGetLastError();
        grid = cus;
    }
    if (grid < 0) return;
    if (hipMemsetAsync((char*)d_ws + WS_CTL, 0, CTL_BYTES, stream) != hipSuccess) { fprintf(stderr, "kernel_launch: memset failed\n"); return; }
    Params a{};
    for (int i = 0; i < 26; ++i) a.in[i] = (const float*)d_in[i];
    a.out = (float*)d_out; a.ws = (unsigned char*)d_ws;
    for (int j = 0; j < 4; ++j) a.invA[j] = pow(500000.0, -(double)j / 4.0);
    for (int j = 0; j < 8; ++j) a.invC[j] = pow(500000.0, -(double)j / 8.0);
    for (int j = 0; j < 16; ++j) a.invB[j] = pow(10000.0, -(double)j / 16.0);
    for (int l = 0; l < NL; ++l) a.lam_init[l] = (float)(0.8 - 0.6 * exp(-0.3 * (double)l));
#if MK_SPLIT
    for (int s = 0; s < NSTEPS; ++s) { a.ph_lo = s; a.ph_hi = s + 1; hipLaunchKernelGGL(mega_fwd, dim3(grid), dim3(NWAVES * 64), LDS_BYTES, stream, a); }
#else
    a.ph_lo = 0; a.ph_hi = NSTEPS * 4;
    hipLaunchKernelGGL(mega_fwd, dim3(grid), dim3(NWAVES * 64), LDS_BYTES, stream, a);
#ifdef PROBE_STEP
    a.ph_lo = PROBE_STEP; a.ph_hi = PROBE_STEP + 1;
    hipLaunchKernelGGL(mega_fwd, dim3(grid), dim3(NWAVES * 64), LDS_BYTES, stream, a);
#endif
#endif
    const hipError_t le = hipPeekAtLastError();
    if (le != hipSuccess) fprintf(stderr, "kernel_launch: launch failed: %s\n", hipGetErrorName(le));
}
```
